# Optimizing an MI355X kernel written in HIP

```python
import math
import jax, jax.numpy as jnp
from jax import lax
import numpy as np

D_MODEL = 1024
BATCH = 32
SEQ = 2048
DEPTH = 2

CHUNK = 64
Q_BLOCK = 128
N_A_LAYERS = DEPTH // 2
N_B_LAYERS = DEPTH - N_A_LAYERS
SSM_GROUP = 16
N_GROUPS = D_MODEL // SSM_GROUP
SSM_STATE = 64
HEAD_DIM = 64
N_HEADS = D_MODEL // HEAD_DIM
D_FF = 2816
CONV_W = 3
EPS = 1e-6
DT_MIN = 1e-3
DT_MAX = 1e-1

kernel_name = "yoco_s5_stickbreak_hybrid"


def rms_norm(x, g):
    xf = x.astype(jnp.float32)
    y = xf * lax.rsqrt(jnp.mean(xf * xf, axis=-1, keepdims=True) + EPS)
    return (y * g.astype(jnp.float32)).astype(x.dtype)


def s5_mixer(xn, w_in, lam_re, lam_im, b_re, b_im, c_re, c_im, d_skip, log_dt, w_glu):
    f32 = jnp.float32
    bsz, seq, _ = xn.shape
    u = (xn @ w_in).astype(f32)
    lam = lax.complex(lam_re.astype(f32), lam_im.astype(f32))
    dt = jnp.exp(log_dt.astype(f32))[:, None]
    a_bar = jnp.exp(lam * dt)
    b_mat = lax.complex(b_re.astype(f32), b_im.astype(f32))
    b_bar = ((a_bar - 1.0) / lam)[..., None] * b_mat
    c_mat = lax.complex(c_re.astype(f32), c_im.astype(f32))
    n_chunks = seq // CHUNK
    u_c = u.reshape(bsz, n_chunks, CHUNK, N_GROUPS, SSM_GROUP).transpose(1, 2, 0, 3, 4)
    a_elems = jnp.broadcast_to(a_bar, (CHUNK, 1, N_GROUPS, SSM_STATE))

    def binop(left, right):
        a_l, b_l = left
        a_r, b_r = right
        return a_r * a_l, a_r * b_l + b_r

    def chunk_step(h0, u_t):
        bu = jnp.einsum('tbgh,gph->tbgp', u_t.astype(jnp.complex64), b_bar)
        a_cum, s = lax.associative_scan(binop, (a_elems, bu), axis=0)
        s = s + a_cum * h0[None]
        y = jnp.einsum('tbgp,ghp->tbgh', s, c_mat).real
        return s[-1], y

    h0 = jnp.zeros((bsz, N_GROUPS, SSM_STATE), jnp.complex64)
    _, y = lax.scan(chunk_step, h0, u_c)
    y = y.transpose(2, 0, 1, 3, 4).reshape(bsz, seq, D_MODEL)
    y = y + d_skip.astype(f32) * u
    g = jax.nn.gelu(y).astype(xn.dtype)
    val, gate = jnp.split(g @ w_glu, 2, axis=-1)
    return val * jax.nn.sigmoid(gate)


def shared_kv(h, kv_norm, w_kv, k_norm):
    bsz, seq, _ = h.shape
    k, v = jnp.split(rms_norm(h, kv_norm) @ w_kv, 2, axis=-1)
    k = rms_norm(k.reshape(bsz, seq, N_HEADS, HEAD_DIM), k_norm)
    v = v.reshape(bsz, seq, N_HEADS, HEAD_DIM)
    return k, v


def stick_breaking_attention(q, k, v):
    seq = q.shape[1]
    scale = HEAD_DIM ** -0.5
    outs = []
    for i in range(seq // Q_BLOCK):
        q0 = i * Q_BLOCK
        kv_len = q0 + Q_BLOCK
        z = jnp.einsum('bqhd,bkhd->bhqk', q[:, q0:kv_len], k[:, :kv_len]).astype(jnp.float32) * scale
        q_pos = q0 + jnp.arange(Q_BLOCK)[:, None]
        k_pos = jnp.arange(kv_len)[None, :]
        causal = k_pos < q_pos
        log_beta = jax.nn.log_sigmoid(z)
        log_1m = jnp.where(causal, log_beta - z, 0.0)
        later = lax.cumsum(log_1m, axis=3, reverse=True) - log_1m
        w = jnp.where(causal, jnp.exp(log_beta + later), 0.0)
        outs.append(jnp.einsum('bhqk,bkhd->bqhd', w.astype(v.dtype), v[:, :kv_len]))
    return jnp.concatenate(outs, axis=1)


def sb_mixer(xn, w_q, q_norm, k, v, w_o):
    bsz, seq, _ = xn.shape
    q = rms_norm((xn @ w_q).reshape(bsz, seq, N_HEADS, HEAD_DIM), q_norm)
    o = stick_breaking_attention(q, k, v)
    return o.reshape(bsz, seq, D_MODEL) @ w_o


def conv_ffn(xn, w_up, conv_w, conv_b, w_down):
    seq = xn.shape[1]
    val, gate = jnp.split(xn @ w_up, 2, axis=-1)
    gp = jnp.pad(gate, ((0, 0), (CONV_W - 1, 0), (0, 0)))
    gc = conv_b + conv_w[0] * gp[:, 0:seq]
    for j in range(1, CONV_W):
        gc = gc + conv_w[j] * gp[:, j:j + seq]
    return (jax.nn.silu(gc) * val) @ w_down


def setup_inputs(seed: int = 0) -> dict:
    key = jax.random.key(seed)
    ks = iter(jax.random.split(key, 32))

    def nrm(shape, scale):
        return scale * jax.random.normal(next(ks), shape, jnp.float32)

    def gain(shape):
        return 1.0 + nrm(shape, 0.02)

    d, f = D_MODEL, D_FF
    na, nb = N_A_LAYERS, N_B_LAYERS
    G, P, H = N_GROUPS, SSM_STATE, SSM_GROUP
    n_idx = jnp.arange(P, dtype=jnp.float32)
    x = nrm((BATCH, SEQ, d), 1.0)
    a_norm = gain((na, d))
    a_w_in = nrm((na, d, d), d ** -0.5)
    a_lam_re = -0.5 + nrm((na, G, P), 0.01)
    a_lam_im = math.pi * n_idx + nrm((na, G, P), 0.01)
    a_b_re = nrm((na, G, P, H), (2 * H) ** -0.5)
    a_b_im = nrm((na, G, P, H), (2 * H) ** -0.5)
    a_c_re = nrm((na, G, H, P), P ** -0.5)
    a_c_im = nrm((na, G, H, P), P ** -0.5)
    a_d = nrm((na, d), 1.0)
    a_log_dt = jax.random.uniform(next(ks), (na, G), jnp.float32, math.log(DT_MIN), math.log(DT_MAX))
    a_w_glu = nrm((na, d, 2 * d), d ** -0.5)
    kv_norm = gain((d,))
    w_kv = nrm((d, 2 * d), d ** -0.5)
    k_norm = gain((HEAD_DIM,))
    b_norm = gain((nb, d))
    b_w_q = nrm((nb, d, d), d ** -0.5)
    b_q_norm = gain((nb, HEAD_DIM))
    b_w_o = nrm((nb, d, d), d ** -0.5)
    ffn_norm = gain((DEPTH, d))
    ffn_w_up = nrm((DEPTH, d, 2 * f), d ** -0.5)
    ffn_conv_w = nrm((DEPTH, CONV_W, f), CONV_W ** -0.5)
    ffn_conv_b = nrm((DEPTH, f), 0.02)
    ffn_w_down = nrm((DEPTH, f, d), f ** -0.5)
    return {"x": x, "a_norm": a_norm, "a_w_in": a_w_in, "a_lam_re": a_lam_re, "a_lam_im": a_lam_im,
            "a_b_re": a_b_re, "a_b_im": a_b_im, "a_c_re": a_c_re, "a_c_im": a_c_im, "a_d": a_d,
            "a_log_dt": a_log_dt, "a_w_glu": a_w_glu, "kv_norm": kv_norm, "w_kv": w_kv, "k_norm": k_norm,
            "b_norm": b_norm, "b_w_q": b_w_q, "b_q_norm": b_q_norm, "b_w_o": b_w_o,
            "ffn_norm": ffn_norm, "ffn_w_up": ffn_w_up, "ffn_conv_w": ffn_conv_w,
            "ffn_conv_b": ffn_conv_b, "ffn_w_down": ffn_w_down}


def reference(x, a_norm, a_w_in, a_lam_re, a_lam_im, a_b_re, a_b_im, a_c_re, a_c_im, a_d,
              a_log_dt, a_w_glu, kv_norm, w_kv, k_norm, b_norm, b_w_q, b_q_norm, b_w_o,
              ffn_norm, ffn_w_up, ffn_conv_w, ffn_conv_b, ffn_w_down):
    h = x
    k = None
    v = None
    for layer in range(DEPTH):
        if layer < N_A_LAYERS:
            i = layer
            h = h + s5_mixer(rms_norm(h, a_norm[i]), a_w_in[i], a_lam_re[i], a_lam_im[i],
                             a_b_re[i], a_b_im[i], a_c_re[i], a_c_im[i], a_d[i], a_log_dt[i], a_w_glu[i])
        else:
            j = layer - N_A_LAYERS
            if j == 0:
                k, v = shared_kv(h, kv_norm, w_kv, k_norm)
            h = h + sb_mixer(rms_norm(h, b_norm[j]), b_w_q[j], b_q_norm[j], k, v, b_w_o[j])
        h = h + conv_ffn(rms_norm(h, ffn_norm[layer]), ffn_w_up[layer], ffn_conv_w[layer],
                         ffn_conv_b[layer], ffn_w_down[layer])
    return h
```

```cpp
#include <hip/hip_runtime.h>
#include <hip/hip_cooperative_groups.h>
#include <cstdio>
#include <cstdint>
namespace cg = cooperative_groups;

#define LAS __attribute__((address_space(3)))
typedef unsigned short bf16_t;
typedef short bf16x8 __attribute__((ext_vector_type(8)));
typedef float f32x4 __attribute__((ext_vector_type(4)));
typedef float f32x16 __attribute__((ext_vector_type(16)));
typedef unsigned u32x4 __attribute__((ext_vector_type(4)));
typedef unsigned u32x2 __attribute__((ext_vector_type(2)));

constexpr int D = 1024, SEQ = 2048, BATCH = 32, M = BATCH * SEQ, FF = 2816, NG = 64, TS = 32  , NCH = SEQ / TS;
constexpr int UP = 640;
constexpr float EPS = 1e-6f;
constexpr size_t MiB = 1u << 20;
constexpr size_t WS_RSTD0 = 1 * MiB, WS_SS1 = WS_RSTD0 + 262144, WS_SS2 = WS_SS1 + 262144, WS_SS3 = WS_SS2 + 262144;
constexpr size_t WS_WIN = 2 * MiB, WS_WGLU = 4 * MiB, WS_WQKV = 8 * MiB, WS_WO = 14 * MiB, WS_UP0 = 16 * MiB, WS_UP1 = 27 * MiB, WS_DN0 = 38 * MiB, WS_DN1 = 44 * MiB;
constexpr size_t WS_TOEP = 50 * MiB, WS_WST = 90 * MiB, WS_AT = 106 * MiB;
constexpr size_t WS_XB = 128 * MiB, WS_GBUF = 480 * MiB  , WS_Q = 128 * MiB;
constexpr size_t WS_UBUF = 256 * MiB, WS_HB = 256 * MiB;
constexpr size_t WS_SLOC = 416 * MiB;
constexpr size_t WS_ACT = 480 * MiB, WS_K = 480 * MiB, WS_V = 608 * MiB, WS_O = 736 * MiB;
constexpr size_t WS_BNDG = 864 * MiB, WS_BNDV = 908 * MiB, WS_END = 930 * MiB;
constexpr int LDS_BYTES = 135168;

__device__ __forceinline__ unsigned f2bf(float f) { unsigned u = __builtin_bit_cast(unsigned, f); return (u + 0x7fffu + ((u >> 16) & 1u)) >> 16; }
__device__ __forceinline__ unsigned pk2(float lo, float hi) { return f2bf(lo) | (f2bf(hi) << 16); }
__device__ __forceinline__ unsigned cvt_pk_bf16(float lo, float hi) { unsigned r; asm volatile("v_cvt_pk_bf16_f32 %0, %1, %2" : "=v"(r) : "v"(lo), "v"(hi)); return r; }
__device__ __forceinline__ float bf_lo(unsigned w) { return __builtin_bit_cast(float, w << 16); }
__device__ __forceinline__ float bf_hi(unsigned w) { return __builtin_bit_cast(float, w & 0xffff0000u); }
__device__ __forceinline__ float sigmoidf_(float y) { return __builtin_amdgcn_rcpf(1.0f + __builtin_amdgcn_exp2f(-1.44269504089f * y)); }
__device__ __forceinline__ float gelu_tanh(float x) { return x * sigmoidf_(1.5957691216f * (x + 0.044715f * x * x * x)); }
template <int CTRL> __device__ __forceinline__ float dppf(float x) { return __builtin_bit_cast(float, __builtin_amdgcn_update_dpp(0, __builtin_bit_cast(int, x), CTRL, 0xf, 0xf, false)); }
__device__ __forceinline__ float wave_sum(float v) {
#pragma unroll
    for (int o = 1; o < 64; o <<= 1) v += __shfl_xor(v, o);
    return v;
}

namespace pg8 {
constexpr int BM = 256, BK = 64, HALF = 128, HTB = HALF * BK * 2, STAGE_BYTES = 8 * HTB, NXCD = 8, WGM = 8;
__host__ __device__ __forceinline__ int lds_byte(int r, int c) { const int st = (r >> 4) * 2 + (c >> 5), rr = r & 15, cc = c & 31, ob = rr * 64 + cc * 2; return st * 1024 + (ob ^ (((ob >> 9) & 1) << 5)); }
__host__ __device__ __forceinline__ void stage_rc(int b, int& R, int& C) { const int st = b / 1024, sb = b % 1024, swz = sb ^ (((sb >> 9) & 1) << 5); R = (st >> 1) * 16 + swz / 64; C = (st & 1) * 32 + (swz % 64) / 2; }
__host__ __device__ __forceinline__ int perm32(int rho) { const int n = rho >> 4, i = rho & 15; return 8 * (i >> 2) + 4 * n + (i & 3); }

struct Unit { int pm, pn; };
struct Gemm { const bf16_t* A; const bf16_t* Bt; int M, N, K; unsigned a_row, a_cg; size_t b_gstride; };

struct StaticOrder {
    int nM, nN, nwg, G, c;
    __device__ void init(int M_, int N_, int G_, int c_) { nM = M_ / BM; nN = N_ / BM; nwg = nM * nN; G = G_; c = c_; }
    __device__ bool next(int i, Unit& u) const {
        const long L = (long)i * G + c; if (L >= nwg) return false;
        int wgid = (int)L; { const int q = nwg / NXCD, r = nwg % NXCD, xcd = wgid % NXCD, off = wgid / NXCD; wgid = (xcd < r ? xcd * (q + 1) : r * (q + 1) + (xcd - r) * q) + off; }
        const int nig = WGM * nN, gid = wgid / nig, fm = gid * WGM, gsz = (nM - fm) < WGM ? (nM - fm) : WGM;
        u.pm = fm + ((wgid % nig) % gsz); u.pn = (wgid % nig) / gsz; return true;
    }
};

template <class Epi>
__device__ __forceinline__ void gemm_phase(LAS unsigned char* lds, const Gemm g, const StaticOrder S, const Epi E) {
    int tid_ = threadIdx.x; asm volatile("" : "+v"(tid_));
    const int tid = tid_, wid = __builtin_amdgcn_readfirstlane(tid >> 6), lane = tid & 63, wr = wid >> 2, wc = wid & 3, fr = lane & 15, fq = lane >> 4;
    const int K = g.K, nt = K / BK;
    unsigned voffA[2], voffB[2];
#pragma unroll
    for (int i = 0; i < 2; ++i) { int R, C; stage_rc(tid * 16 + i * 8192, R, C); const int Rb = Epi::PERM ? ((R & ~31) + perm32(R & 31)) : R;
        const int Ra = Epi::ROWPERM ? ((R & ~63) | ((R & 15) << 2) | ((R >> 4) & 3)) : R;
        voffA[i] = (unsigned)(C >> 4) * g.a_cg + (unsigned)Ra * g.a_row + (unsigned)(C & 15) * 2u; voffB[i] = (unsigned)(Rb * K + C) * 2u; }
    const size_t kstepA = (size_t)g.a_cg * 4, kstepB = (size_t)(BK * 2);
    const size_t hstepA = (size_t)HALF * g.a_row, hstepB = (size_t)HALF * K * 2;
    const size_t tstepA = 2 * hstepA, tstepB = 2 * hstepB;
    const unsigned ldsw = (unsigned)wid * 1024u;
    const int aoff = lds_byte(wr * 64 + fr, fq * 8), boff = lds_byte(wc * 32 + fr, fq * 8);
#define PG8_SA(b, h) (((b) * 2 + (h)) * HTB)
#define PG8_SB(b, h) ((4 + (b) * 2 + (h)) * HTB)
#define PG8_STAGE(bufoff, gbase, voff) do { _Pragma("unroll") for (int _i = 0; _i < 2; ++_i) \
        __builtin_amdgcn_global_load_lds((const unsigned*)((const char*)(gbase) + (voff)[_i]), (LAS unsigned*)(lds + (bufoff) + ldsw + _i * 8192), 16, 0, 0); } while (0)
#define PG8_LDA(dst, b, h) do { _Pragma("unroll") for (int m = 0; m < 4; ++m) _Pragma("unroll") for (int k = 0; k < 2; ++k) dst[m][k] = *(const LAS bf16x8*)(lds + PG8_SA(b, h) + aoff + m * 2048 + k * 1024); } while (0)
#define PG8_LDB(dst, b, h) do { _Pragma("unroll") for (int n = 0; n < 2; ++n) _Pragma("unroll") for (int k = 0; k < 2; ++k) dst[n][k] = *(const LAS bf16x8*)(lds + PG8_SB(b, h) + boff + n * 2048 + k * 1024); } while (0)
#define PG8_MMA(ai, bj, At, Bt) do { __builtin_amdgcn_s_setprio(1); _Pragma("unroll") for (int m = 0; m < 4; ++m) _Pragma("unroll") for (int n = 0; n < 2; ++n) _Pragma("unroll") for (int k = 0; k < 2; ++k) \
        acc[ai][bj][m][n] = __builtin_amdgcn_mfma_f32_16x16x32_bf16(Bt[n][k], At[m][k], acc[ai][bj][m][n], 0, 0, 0); __builtin_amdgcn_s_setprio(0); } while (0)
#define PG8_WAIT_V(n) asm volatile("s_waitcnt vmcnt(" #n ")" ::: "memory")
#define PG8_WAIT_L(n) asm volatile("s_waitcnt lgkmcnt(" #n ")" ::: "memory")
#define PG8_BAR __builtin_amdgcn_s_barrier()
#define PG8_SCHED __builtin_amdgcn_sched_barrier(0)
    Unit cur, nxt; int ui = 0;
    if (!S.next(0, cur)) return;
    f32x4 acc[2][2][4][2];
#pragma unroll
    for (int a = 0; a < 2; ++a)
#pragma unroll
        for (int b = 0; b < 2; ++b)
#pragma unroll
            for (int m = 0; m < 4; ++m)
#pragma unroll
                for (int n = 0; n < 2; ++n) acc[a][b][m][n] = (f32x4){0.f, 0.f, 0.f, 0.f};
    bf16x8 At[4][2], B0[2][2], B1[2][2];
    const char* cA = (const char*)g.A + (size_t)cur.pm * tstepA; const char* cB = (const char*)g.Bt + (size_t)(cur.pm >> 3) * g.b_gstride + (size_t)cur.pn * tstepB;
    PG8_STAGE(PG8_SB(0, 0), cB, voffB); PG8_STAGE(PG8_SB(0, 1), cB + hstepB, voffB); PG8_STAGE(PG8_SA(0, 0), cA, voffA); PG8_STAGE(PG8_SA(0, 1), cA + hstepA, voffA);
    if (wr == 1) PG8_BAR;
    PG8_WAIT_V(2); PG8_BAR;
    PG8_STAGE(PG8_SB(1, 0), cB + kstepB, voffB); PG8_STAGE(PG8_SA(1, 0), cA + kstepA, voffA); PG8_STAGE(PG8_SB(1, 1), cB + hstepB + kstepB, voffB);
    PG8_WAIT_V(6); PG8_BAR;
    for (;;) {
        const bool has_next = S.next(ui + 1, nxt);
        const char* nA = has_next ? (const char*)g.A + (size_t)nxt.pm * tstepA : cA;
        const char* nB = has_next ? (const char*)g.Bt + (size_t)(nxt.pm >> 3) * g.b_gstride + (size_t)nxt.pn * tstepB : cB;
        for (int t = 0; t < nt; t += 2) {
            const bool last = (t == nt - 2);
            const char* a1 = cA + (size_t)(t + 1) * kstepA;
            const char* a2 = last ? nA : cA + (size_t)(t + 2) * kstepA; const char* b2 = last ? nB : cB + (size_t)(t + 2) * kstepB;
            const char* a3 = a2 + kstepA; const char* b3 = b2 + kstepB;
            PG8_LDB(B0, 0, 0); PG8_LDB(B1, 0, 1); PG8_SCHED; PG8_LDA(At, 0, 0); PG8_STAGE(PG8_SA(1, 1), a1 + hstepA, voffA);
            PG8_WAIT_V(8); PG8_WAIT_L(0); PG8_BAR; PG8_MMA(0, 0, At, B0); PG8_MMA(0, 1, At, B1); PG8_BAR; PG8_SCHED;
            PG8_LDA(At, 0, 1); PG8_STAGE(PG8_SB(0, 0), b2, voffB); PG8_STAGE(PG8_SB(0, 1), b2 + hstepB, voffB); PG8_STAGE(PG8_SA(0, 0), a2, voffA);
            PG8_WAIT_V(8); PG8_WAIT_L(0); PG8_BAR; PG8_MMA(1, 0, At, B0); PG8_MMA(1, 1, At, B1); PG8_BAR; PG8_SCHED;
            PG8_LDB(B0, 1, 0); PG8_LDB(B1, 1, 1); PG8_SCHED; PG8_LDA(At, 1, 0); PG8_STAGE(PG8_SA(0, 1), a2 + hstepA, voffA);
            PG8_WAIT_V(8); PG8_WAIT_L(0); PG8_BAR; PG8_MMA(0, 0, At, B0); PG8_MMA(0, 1, At, B1); PG8_BAR; PG8_SCHED;
            PG8_LDA(At, 1, 1); PG8_STAGE(PG8_SB(1, 0), b3, voffB); PG8_STAGE(PG8_SB(1, 1), b3 + hstepB, voffB); PG8_STAGE(PG8_SA(1, 0), a3, voffA);
            PG8_WAIT_V(8); PG8_WAIT_L(0); PG8_BAR; PG8_MMA(1, 0, At, B0); PG8_MMA(1, 1, At, B1); PG8_BAR; PG8_SCHED;
        }
        if (wr == 0) PG8_BAR;
        E(acc, cur, wr, wc, fr, fq);
        if (!has_next) break;
#pragma unroll
        for (int a = 0; a < 2; ++a)
#pragma unroll
            for (int b = 0; b < 2; ++b)
#pragma unroll
                for (int m = 0; m < 4; ++m)
#pragma unroll
                    for (int n = 0; n < 2; ++n) acc[a][b][m][n] = (f32x4){0.f, 0.f, 0.f, 0.f};
        cur = nxt; cA = nA; cB = nB; ++ui;
        if (wr == 1) PG8_BAR;
    }
    PG8_WAIT_V(0);
    PG8_BAR;
#undef PG8_SA
#undef PG8_SB
#undef PG8_STAGE
#undef PG8_LDA
#undef PG8_LDB
#undef PG8_MMA
#undef PG8_WAIT_V
#undef PG8_WAIT_L
#undef PG8_BAR
#undef PG8_SCHED
}
}
using pg8::Unit;
typedef const f32x4 (&AccRef)[2][2][4][2];

#define EPI_FENCE() __builtin_amdgcn_sched_barrier(0)
#define EPI_ROW(ai, m) (u.pm * 256 + (ai) * 128 + wr * 64 + (m) * 16 + fr)
struct EpiU {
    static constexpr bool PERM = true, ROWPERM = false;
    const float* rstd; bf16_t* U;
    __device__ __forceinline__ void operator()(AccRef acc, const Unit& u, int wr, int wc, int fr, int fq) const {
        float rs[2][4];
#pragma unroll
        for (int ai = 0; ai < 2; ++ai)
#pragma unroll
            for (int m = 0; m < 4; ++m) rs[ai][m] = rstd[EPI_ROW(ai, m)];
        EPI_FENCE();
#pragma unroll
        for (int ai = 0; ai < 2; ++ai)
#pragma unroll
            for (int m = 0; m < 4; ++m) {
                const int row = EPI_ROW(ai, m);
                bf16_t* base = U + (size_t)(row >> 5) * UP + (row & 31) * 16;
#pragma unroll
                for (int bj = 0; bj < 2; ++bj) { const int ch0 = u.pn * 256 + bj * 128 + wc * 32 + 8 * fq; const int gg = ch0 >> 4, h0 = ch0 & 15;
                    const f32x4 v0 = acc[ai][bj][m][0] * rs[ai][m], v1 = acc[ai][bj][m][1] * rs[ai][m];
                    u32x4 w; w.x = cvt_pk_bf16(v0[0], v0[1]); w.y = cvt_pk_bf16(v0[2], v0[3]); w.z = cvt_pk_bf16(v1[0], v1[1]); w.w = cvt_pk_bf16(v1[2], v1[3]);
                    *(u32x4*)(base + (size_t)gg * (2048 * UP) + h0) = w; } }
    }
};
struct EpiSloc {
    static constexpr bool PERM = false, ROWPERM = false;
    float* S;
    __device__ __forceinline__ void operator()(AccRef acc, const Unit& u, int wr, int wc, int fr, int fq) const {
#pragma unroll
        for (int ai = 0; ai < 2; ++ai)
#pragma unroll
            for (int m = 0; m < 4; ++m) { const int row = EPI_ROW(ai, m);
#pragma unroll
                for (int n = 0; n < 2; ++n) *(f32x4*)(S + (size_t)row * 128 + wc * 32 + 16 * n + 4 * fq) = acc[ai][0][m][n]; }
    }
};
struct EpiSsmOut {
    static constexpr bool PERM = true, ROWPERM = false;
    const bf16_t* U; const float* dskip; bf16_t* G;
    __device__ __forceinline__ void operator()(AccRef acc, const Unit& u, int wr, int wc, int fr, int fq) const {
        const int gg = u.pm >> 3;
#pragma unroll
        for (int bj = 0; bj < 2; ++bj) { const int col0 = u.pn * 256 + bj * 128 + wc * 32 + 8 * fq; const int h0 = col0 & 15;
            const f32x4 d0 = *(const f32x4*)(dskip + gg * 16 + h0), d1 = *(const f32x4*)(dskip + gg * 16 + h0 + 4);
            u32x4 uu[2][4];
#pragma unroll
            for (int ai = 0; ai < 2; ++ai)
#pragma unroll
                for (int m = 0; m < 4; ++m) uu[ai][m] = *(const u32x4*)(U + (size_t)EPI_ROW(ai, m) * UP + col0);
            EPI_FENCE();
#pragma unroll
            for (int ai = 0; ai < 2; ++ai)
#pragma unroll
                for (int m = 0; m < 4; ++m) { const int row = EPI_ROW(ai, m); const u32x4 q = uu[ai][m];
                    f32x4 y0 = acc[ai][bj][m][0], y1 = acc[ai][bj][m][1];
                    y0[0] += d0[0] * bf_lo(q.x); y0[1] += d0[1] * bf_hi(q.x); y0[2] += d0[2] * bf_lo(q.y); y0[3] += d0[3] * bf_hi(q.y);
                    y1[0] += d1[0] * bf_lo(q.z); y1[1] += d1[1] * bf_hi(q.z); y1[2] += d1[2] * bf_lo(q.w); y1[3] += d1[3] * bf_hi(q.w);
                    u32x4 w; w.x = cvt_pk_bf16(gelu_tanh(y0[0]), gelu_tanh(y0[1])); w.y = cvt_pk_bf16(gelu_tanh(y0[2]), gelu_tanh(y0[3]));
                    w.z = cvt_pk_bf16(gelu_tanh(y1[0]), gelu_tanh(y1[1])); w.w = cvt_pk_bf16(gelu_tanh(y1[2]), gelu_tanh(y1[3]));
                    *(u32x4*)(G + (size_t)row * 512 + col0) = w; }
            EPI_FENCE(); }
    }
};
struct EpiGlu {
    static constexpr bool PERM = true, ROWPERM = false;
    const bf16_t* xb; bf16_t* hb; float* ss;
    __device__ __forceinline__ void operator()(AccRef acc, const Unit& u, int wr, int wc, int fr, int fq) const {
        u32x4 xr[2][4];
#pragma unroll
        for (int ai = 0; ai < 2; ++ai)
#pragma unroll
            for (int m = 0; m < 4; ++m) xr[ai][m] = *(const u32x4*)(xb + (size_t)EPI_ROW(ai, m) * D + u.pn * 128 + wc * 32 + 8 * fq);
        EPI_FENCE();
#pragma unroll
        for (int ai = 0; ai < 2; ++ai)
#pragma unroll
            for (int m = 0; m < 4; ++m) { const int row = EPI_ROW(ai, m); const size_t off = (size_t)row * D + u.pn * 128 + wc * 32 + 8 * fq;
                const u32x4 q = xr[ai][m]; const f32x4 v0 = acc[ai][0][m][0], v1 = acc[ai][0][m][1], g0 = acc[ai][1][m][0], g1 = acc[ai][1][m][1];
                f32x4 h0, h1;
                h0[0] = bf_lo(q.x) + v0[0] * sigmoidf_(g0[0]); h0[1] = bf_hi(q.x) + v0[1] * sigmoidf_(g0[1]); h0[2] = bf_lo(q.y) + v0[2] * sigmoidf_(g0[2]); h0[3] = bf_hi(q.y) + v0[3] * sigmoidf_(g0[3]);
                h1[0] = bf_lo(q.z) + v1[0] * sigmoidf_(g1[0]); h1[1] = bf_hi(q.z) + v1[1] * sigmoidf_(g1[1]); h1[2] = bf_lo(q.w) + v1[2] * sigmoidf_(g1[2]); h1[3] = bf_hi(q.w) + v1[3] * sigmoidf_(g1[3]);
                u32x4 w; w.x = cvt_pk_bf16(h0[0], h0[1]); w.y = cvt_pk_bf16(h0[2], h0[3]); w.z = cvt_pk_bf16(h1[0], h1[1]); w.w = cvt_pk_bf16(h1[2], h1[3]);
                *(u32x4*)(hb + off) = w;
                float s2 = (bf_lo(w.x) * bf_lo(w.x) + bf_hi(w.x) * bf_hi(w.x)) + (bf_lo(w.y) * bf_lo(w.y) + bf_hi(w.y) * bf_hi(w.y)) + (bf_lo(w.z) * bf_lo(w.z) + bf_hi(w.z) * bf_hi(w.z)) + (bf_lo(w.w) * bf_lo(w.w) + bf_hi(w.w) * bf_hi(w.w));
                s2 += __shfl_xor(s2, 16); s2 += __shfl_xor(s2, 32);
                if (fq == 0) unsafeAtomicAdd(ss + row, s2); }
    }
};
template <bool LAST> struct EpiResid {
    static constexpr bool PERM = true, ROWPERM = false;
    float* out; bf16_t* hb; float* ss;
    __device__ __forceinline__ void operator()(AccRef acc, const Unit& u, int wr, int wc, int fr, int fq) const {
#pragma unroll
        for (int ai = 0; ai < 2; ++ai) {
            u32x4 rr[4][2];
#pragma unroll
            for (int m = 0; m < 4; ++m)
#pragma unroll
                for (int bj = 0; bj < 2; ++bj) rr[m][bj] = *(const u32x4*)(hb + (size_t)EPI_ROW(ai, m) * D + u.pn * 256 + bj * 128 + wc * 32 + 8 * fq);
            EPI_FENCE();
#pragma unroll
            for (int m = 0; m < 4; ++m) { const int row = EPI_ROW(ai, m); float s = 0.f;
#pragma unroll
                for (int bj = 0; bj < 2; ++bj) { const size_t off = (size_t)row * D + u.pn * 256 + bj * 128 + wc * 32 + 8 * fq;
                    const u32x4 r = rr[m][bj]; f32x4 h0 = acc[ai][bj][m][0], h1 = acc[ai][bj][m][1];
                    h0[0] += bf_lo(r.x); h0[1] += bf_hi(r.x); h0[2] += bf_lo(r.y); h0[3] += bf_hi(r.y); h1[0] += bf_lo(r.z); h1[1] += bf_hi(r.z); h1[2] += bf_lo(r.w); h1[3] += bf_hi(r.w);
                    if (LAST) { *(f32x4*)(out + off) = h0; *(f32x4*)(out + off + 4) = h1; }
                    else { u32x4 w; w.x = cvt_pk_bf16(h0[0], h0[1]); w.y = cvt_pk_bf16(h0[2], h0[3]); w.z = cvt_pk_bf16(h1[0], h1[1]); w.w = cvt_pk_bf16(h1[2], h1[3]);
                        *(u32x4*)(hb + off) = w;
                        s += (bf_lo(w.x) * bf_lo(w.x) + bf_hi(w.x) * bf_hi(w.x)) + (bf_lo(w.y) * bf_lo(w.y) + bf_hi(w.y) * bf_hi(w.y)) + (bf_lo(w.z) * bf_lo(w.z) + bf_hi(w.z) * bf_hi(w.z)) + (bf_lo(w.w) * bf_lo(w.w) + bf_hi(w.w) * bf_hi(w.w)); } }
                if (!LAST) { s += __shfl_xor(s, 16); s += __shfl_xor(s, 32); if (fq == 0) unsafeAtomicAdd(ss + row, s); } }
            EPI_FENCE(); }
    }
};
typedef float f32x2 __attribute__((ext_vector_type(2)));
template <int CTRL> __device__ __forceinline__ float dpp_old(float old, float x) { return __builtin_bit_cast(float, __builtin_amdgcn_update_dpp(__builtin_bit_cast(int, old), __builtin_bit_cast(int, x), CTRL, 0xf, 0xf, false)); }
__device__ __forceinline__ f32x2 silu_mul2(f32x2 gc, f32x2 v) {
    const f32x2 t = gc * (-1.44269504089f); f32x2 e; e.x = __builtin_amdgcn_exp2f(t.x); e.y = __builtin_amdgcn_exp2f(t.y);
    const f32x2 d = e + 1.0f; f32x2 r; r.x = __builtin_amdgcn_rcpf(d.x); r.y = __builtin_amdgcn_rcpf(d.y);
    return (gc * v) * r;
}
struct EpiUp {
    static constexpr bool PERM = true, ROWPERM = true;
    const float* ss; const float* cw; const float* cb; bf16_t* act; bf16_t* bndg;
#define UP_ROW(ai, m) (u.pm * 256 + (ai) * 128 + wr * 64 + 4 * fr + (m))
    __device__ __forceinline__ void operator()(AccRef acc, const Unit& u, int wr, int wc, int fr, int fq) const {
        const int ch0 = u.pn * 128 + wc * 32 + 8 * fq;
        f32x4 w0[2], w1[2], w2[2], bb[2]; float rs[2][4];
#pragma unroll
        for (int n = 0; n < 2; ++n) { w0[n] = *(const f32x4*)(cw + ch0 + 4 * n); w1[n] = *(const f32x4*)(cw + FF + ch0 + 4 * n); w2[n] = *(const f32x4*)(cw + 2 * FF + ch0 + 4 * n); bb[n] = *(const f32x4*)(cb + ch0 + 4 * n); }
#pragma unroll
        for (int ai = 0; ai < 2; ++ai) { const f32x4 q = *(const f32x4*)(ss + UP_ROW(ai, 0)); rs[ai][0] = q[0]; rs[ai][1] = q[1]; rs[ai][2] = q[2]; rs[ai][3] = q[3]; }
        EPI_FENCE();
#pragma unroll
        for (int ai = 0; ai < 2; ++ai) {
            f32x4 gt[4][2], vv[4][2], o[4][2];
#pragma unroll
            for (int m = 0; m < 4; ++m) { const float rsc = __builtin_amdgcn_rsqf(rs[ai][m] * (1.0f / D) + EPS);
#pragma unroll
                for (int n = 0; n < 2; ++n) { gt[m][n] = acc[ai][1][m][n] * rsc; vv[m][n] = acc[ai][0][m][n] * rsc; } }
#pragma unroll
            for (int n = 0; n < 2; ++n)
#pragma unroll
                for (int jp = 0; jp < 4; jp += 2) {
                    const f32x2 g0 = (f32x2){gt[0][n][jp], gt[0][n][jp + 1]}, g1 = (f32x2){gt[1][n][jp], gt[1][n][jp + 1]}, g2 = (f32x2){gt[2][n][jp], gt[2][n][jp + 1]}, g3 = (f32x2){gt[3][n][jp], gt[3][n][jp + 1]};
                    f32x2 s3, s2; s3.x = dpp_old<0x111>(0.f, g3.x); s3.y = dpp_old<0x111>(0.f, g3.y); s2.x = dpp_old<0x111>(0.f, g2.x); s2.y = dpp_old<0x111>(0.f, g2.y);
                    const f32x2 k0 = (f32x2){w0[n][jp], w0[n][jp + 1]}, k1 = (f32x2){w1[n][jp], w1[n][jp + 1]}, k2 = (f32x2){w2[n][jp], w2[n][jp + 1]}, kb = (f32x2){bb[n][jp], bb[n][jp + 1]};
                    const f32x2 c0 = k0 * s2 + (k1 * s3 + (k2 * g0 + kb)), c1 = k0 * s3 + (k1 * g0 + (k2 * g1 + kb)), c2 = k0 * g0 + (k1 * g1 + (k2 * g2 + kb)), c3 = k0 * g1 + (k1 * g2 + (k2 * g3 + kb));
                    const f32x2 o0 = silu_mul2(c0, (f32x2){vv[0][n][jp], vv[0][n][jp + 1]}), o1 = silu_mul2(c1, (f32x2){vv[1][n][jp], vv[1][n][jp + 1]});
                    const f32x2 o2 = silu_mul2(c2, (f32x2){vv[2][n][jp], vv[2][n][jp + 1]}), o3 = silu_mul2(c3, (f32x2){vv[3][n][jp], vv[3][n][jp + 1]});
                    o[0][n][jp] = o0.x; o[0][n][jp + 1] = o0.y; o[1][n][jp] = o1.x; o[1][n][jp + 1] = o1.y; o[2][n][jp] = o2.x; o[2][n][jp + 1] = o2.y; o[3][n][jp] = o3.x; o[3][n][jp + 1] = o3.y; }
#pragma unroll
            for (int m = 0; m < 4; ++m) { const int row = UP_ROW(ai, m); const int r64 = 4 * fr + m; const size_t blk = (size_t)(row >> 6);
                if (r64 >= 2) { u32x4 w; w.x = cvt_pk_bf16(o[m][0][0], o[m][0][1]); w.y = cvt_pk_bf16(o[m][0][2], o[m][0][3]); w.z = cvt_pk_bf16(o[m][1][0], o[m][1][1]); w.w = cvt_pk_bf16(o[m][1][2], o[m][1][3]);
                    *(u32x4*)(act + (size_t)row * FF + ch0) = w; }
                else { u32x4 wg, wv; wg.x = cvt_pk_bf16(gt[m][0][0], gt[m][0][1]); wg.y = cvt_pk_bf16(gt[m][0][2], gt[m][0][3]); wg.z = cvt_pk_bf16(gt[m][1][0], gt[m][1][1]); wg.w = cvt_pk_bf16(gt[m][1][2], gt[m][1][3]);
                       wv.x = cvt_pk_bf16(vv[m][0][0], vv[m][0][1]); wv.y = cvt_pk_bf16(vv[m][0][2], vv[m][0][3]); wv.z = cvt_pk_bf16(vv[m][1][0], vv[m][1][1]); wv.w = cvt_pk_bf16(vv[m][1][2], vv[m][1][3]);
                       *(u32x4*)(bndg + (blk * 4 + 2 + r64) * FF + ch0) = wg; *(u32x4*)(act + (size_t)row * FF + ch0) = wv; }
                if (r64 >= 62) { u32x4 wg; wg.x = cvt_pk_bf16(gt[m][0][0], gt[m][0][1]); wg.y = cvt_pk_bf16(gt[m][0][2], gt[m][0][3]); wg.z = cvt_pk_bf16(gt[m][1][0], gt[m][1][1]); wg.w = cvt_pk_bf16(gt[m][1][2], gt[m][1][3]);
                    *(u32x4*)(bndg + (blk * 4 + (r64 - 62)) * FF + ch0) = wg; } } }
    }
#undef UP_ROW
};
struct EpiQkv {
    static constexpr bool PERM = true, ROWPERM = false;
    const float* ss; const float* qn; const float* kn; bf16_t* Q; bf16_t* Kb;
    __device__ __forceinline__ void operator()(AccRef acc, const Unit& u, int wr, int wc, int fr, int fq) const {
        const int part = u.pn >> 2, head = (u.pn & 3) * 4 + wc;
        const bf16_t* q_ = Q; const bf16_t* k_ = Kb; const float* qn_ = qn; const float* kn_ = kn;
        bf16_t* dst = (bf16_t*)((uintptr_t)q_ + (part > 0 ? (uintptr_t)k_ - (uintptr_t)q_ : 0));
        const float* gn = (const float*)((uintptr_t)qn_ + (part > 0 ? (uintptr_t)kn_ - (uintptr_t)qn_ : 0));
        const float post = part == 0 ? 0.125f * 1.44269504089f : 1.0f;
        f32x4 g[2][2]; float rs[2][4];
#pragma unroll
        for (int bj = 0; bj < 2; ++bj)
#pragma unroll
            for (int n = 0; n < 2; ++n) g[bj][n] = *(const f32x4*)(gn + 32 * bj + 8 * fq + 4 * n) * post;
#pragma unroll
        for (int ai = 0; ai < 2; ++ai)
#pragma unroll
            for (int m = 0; m < 4; ++m) rs[ai][m] = ss[EPI_ROW(ai, m)];
        EPI_FENCE();
#pragma unroll
        for (int ai = 0; ai < 2; ++ai)
#pragma unroll
            for (int m = 0; m < 4; ++m) { const int row = EPI_ROW(ai, m); const float rsc = __builtin_amdgcn_rsqf(rs[ai][m] * (1.0f / D) + EPS);
                f32x4 v[2][2]; float s = 0.f;
#pragma unroll
                for (int bj = 0; bj < 2; ++bj)
#pragma unroll
                    for (int n = 0; n < 2; ++n) { v[bj][n] = acc[ai][bj][m][n] * rsc; s += (v[bj][n][0] * v[bj][n][0] + v[bj][n][1] * v[bj][n][1]) + (v[bj][n][2] * v[bj][n][2] + v[bj][n][3] * v[bj][n][3]); }
                s += __shfl_xor(s, 16); s += __shfl_xor(s, 32);
                const float hr = __builtin_amdgcn_rsqf(s * (1.0f / 64.0f) + EPS);
#pragma unroll
                for (int bj = 0; bj < 2; ++bj) { f32x4 a = v[bj][0], b = v[bj][1];
                    a = a * hr * g[bj][0]; b = b * hr * g[bj][1];
                    u32x4 w; w.x = cvt_pk_bf16(a[0], a[1]); w.y = cvt_pk_bf16(a[2], a[3]); w.z = cvt_pk_bf16(b[0], b[1]); w.w = cvt_pk_bf16(b[2], b[3]);
                    *(u32x4*)(dst + (size_t)row * D + head * 64 + 32 * bj + 8 * fq) = w; } }
    }
};
struct EpiVt {
    static constexpr bool PERM = true, ROWPERM = false;
    const float* ss; bf16_t* Vt;
    __device__ __forceinline__ void operator()(AccRef acc, const Unit& u, int wr, int wc, int fr, int fq) const {
        f32x4 r0[2], r1[2];
#pragma unroll
        for (int bj = 0; bj < 2; ++bj) { const int tok0 = u.pn * 256 + bj * 128 + wc * 32 + 8 * fq; r0[bj] = *(const f32x4*)(ss + tok0); r1[bj] = *(const f32x4*)(ss + tok0 + 4); }
        EPI_FENCE();
#pragma unroll
        for (int bj = 0; bj < 2; ++bj) { const int tok0 = u.pn * 256 + bj * 128 + wc * 32 + 8 * fq;
#pragma unroll
            for (int j = 0; j < 4; ++j) { r0[bj][j] = __builtin_amdgcn_rsqf(r0[bj][j] * (1.0f / D) + EPS); r1[bj][j] = __builtin_amdgcn_rsqf(r1[bj][j] * (1.0f / D) + EPS); }
#pragma unroll
            for (int ai = 0; ai < 2; ++ai)
#pragma unroll
                for (int m = 0; m < 4; ++m) { const int row = EPI_ROW(ai, m); const f32x4 a = acc[ai][bj][m][0] * r0[bj], b = acc[ai][bj][m][1] * r1[bj];
                    u32x4 w; w.x = cvt_pk_bf16(a[0], a[1]); w.y = cvt_pk_bf16(a[2], a[3]); w.z = cvt_pk_bf16(b[0], b[1]); w.w = cvt_pk_bf16(b[2], b[3]);
                    *(u32x4*)(Vt + (size_t)row * M + tok0) = w; } }
    }
};

__device__ __forceinline__ void sincos_red(double ang, float& c, float& s) {
    const double q = __builtin_rint(ang * 0.63661977236758134308);
    double y = __builtin_fma(-q, 1.57079632679489655800, ang); y = __builtin_fma(-q, 6.123233995736766e-17, y);
    const int qi = (int)((long long)q & 3);
    const double y2 = y * y;
    const double sp = y * (1.0 + y2 * (-1.0 / 6 + y2 * (1.0 / 120 + y2 * (-1.0 / 5040 + y2 * (1.0 / 362880 + y2 * (-1.0 / 39916800 + y2 * (1.0 / 6227020800.0)))))));
    const double cp = 1.0 + y2 * (-0.5 + y2 * (1.0 / 24 + y2 * (-1.0 / 720 + y2 * (1.0 / 40320 + y2 * (-1.0 / 3628800 + y2 * (1.0 / 479001600.0))))));
    const float sf = (float)sp, cf = (float)cp;
    c = (qi == 0) ? cf : (qi == 1) ? -sf : (qi == 2) ? -cf : sf;
    s = (qi == 0) ? sf : (qi == 1) ? cf : (qi == 2) ? -sf : -cf;
}
__device__ __forceinline__ void p0_ssm_consts(int g, int qd, const float* lam_re, const float* lam_im, const float* b_re, const float* b_im, const float* c_re, const float* c_im, const float* log_dt,
                                              bf16_t* toep, bf16_t* wst, float* at, LAS float* L, int tid) {
    LAS float* AP = L; LAS float* BB = L + 4224; LAS float* CM = BB + 2048; LAS float* KM = CM + 2048;
    const double dt = exp((double)log_dt[g]);
    for (int it = tid; it < 64 * 33; it += 512) { const int p = it / 33, j = it % 33;
        const double re = (double)lam_re[g * 64 + p] * dt * j, im = (double)lam_im[g * 64 + p] * dt * j;
        float c, s; sincos_red(im, c, s); const float mg = (float)exp(re);
        AP[it * 2] = mg * c; AP[it * 2 + 1] = mg * s; }
    for (int it = tid; it < 1024; it += 512) { const int h = it >> 6, p = it & 63; CM[it * 2] = c_re[(g * 16 + h) * 64 + p]; CM[it * 2 + 1] = c_im[(g * 16 + h) * 64 + p]; }
    __syncthreads();
    for (int it = tid; it < 1024; it += 512) { const int p = it >> 4, h = it & 15;
        const float lr = lam_re[g * 64 + p], li = lam_im[g * 64 + p], xr = AP[(p * 33 + 1) * 2] - 1.0f, xi = AP[(p * 33 + 1) * 2 + 1];
        const float den = 1.0f / (lr * lr + li * li), zr = (xr * lr + xi * li) * den, zi = (xi * lr - xr * li) * den;
        const float br = b_re[(g * 64 + p) * 16 + h], bi = b_im[(g * 64 + p) * 16 + h];
        BB[it * 2] = zr * br - zi * bi; BB[it * 2 + 1] = zr * bi + zi * br; }
    if (qd == 0 && tid < 64) { at[(g * 64 + tid) * 2] = AP[(tid * 33 + 32) * 2]; at[(g * 64 + tid) * 2 + 1] = AP[(tid * 33 + 32) * 2 + 1]; }
    __syncthreads();
    for (int o = tid; o < 2048; o += 512) { const int j = o >> 6, hl = (o >> 4) & 3, hp = o & 15, h = 4 * qd + hl; float acc = 0.f;
        for (int p = 0; p < 64; ++p) { const float cr = CM[(h * 64 + p) * 2], ci = CM[(h * 64 + p) * 2 + 1], ar = AP[(p * 33 + j) * 2], ai = AP[(p * 33 + j) * 2 + 1];
            const float er = cr * ar - ci * ai, ei = cr * ai + ci * ar; acc += er * BB[(p * 16 + hp) * 2] - ei * BB[(p * 16 + hp) * 2 + 1]; }
        KM[o] = acc; }
    __syncthreads();
    bf16_t* tg = toep + (size_t)g * 512 * UP;
    for (int ci = tid; ci < 128 * 80; ci += 512) { const int rl = ci / 80, col0 = (ci % 80) * 8, t = rl >> 2, hl = rl & 3, h = 4 * qd + hl, row = t * 16 + h; float v[8];
        if (col0 < 512) { const int s = col0 >> 4, h0 = col0 & 15;
#pragma unroll
            for (int e = 0; e < 8; ++e) v[e] = (s <= t) ? KM[((t - s) * 4 + hl) * 16 + h0 + e] : 0.f; }
        else { const int q0 = col0 - 512; const bool imp = q0 >= 64; const int p0 = imp ? q0 - 64 : q0;
#pragma unroll
            for (int e = 0; e < 8; ++e) { const int p = p0 + e; const float cr = CM[(h * 64 + p) * 2], cim = CM[(h * 64 + p) * 2 + 1], ar = AP[(p * 33 + t + 1) * 2], aim = AP[(p * 33 + t + 1) * 2 + 1];
                v[e] = imp ? -(cr * aim + cim * ar) : (cr * ar - cim * aim); } }
        u32x4 w; w.x = pk2(v[0], v[1]); w.y = pk2(v[2], v[3]); w.z = pk2(v[4], v[5]); w.w = pk2(v[6], v[7]);
        *(u32x4*)(tg + (size_t)row * UP + col0) = w; }
    bf16_t* wg = wst + (size_t)g * 256 * 512;
    for (int ci = tid; ci < 64 * 64; ci += 512) { const int q = 64 * qd + (ci >> 6), col0 = (ci & 63) * 8, s = col0 >> 4, h0 = col0 & 15; float v[8];
        if (q < 128) { const bool imp = q >= 64; const int p = imp ? q - 64 : q; const float ar = AP[(p * 33 + 31 - s) * 2], aim = AP[(p * 33 + 31 - s) * 2 + 1];
#pragma unroll
            for (int e = 0; e < 8; ++e) { const float br = BB[(p * 16 + h0 + e) * 2], bi = BB[(p * 16 + h0 + e) * 2 + 1]; v[e] = imp ? (ar * bi + aim * br) : (ar * br - aim * bi); } }
        else {
#pragma unroll
            for (int e = 0; e < 8; ++e) v[e] = 0.f; }
        u32x4 w; w.x = pk2(v[0], v[1]); w.y = pk2(v[2], v[3]); w.z = pk2(v[4], v[5]); w.w = pk2(v[6], v[7]);
        *(u32x4*)(wg + (size_t)q * 512 + col0) = w; }
    __syncthreads();
}
__device__ __forceinline__ void p0_transpose_item(const float* W, int K, int Nsrc, const float* gain, bf16_t* WT, int k0, int srccol0, int dstrow0, LAS float* scr, int lane) {
    float v[32];
#pragma unroll
    for (int i = 0; i < 32; ++i) { const int kk = 2 * i + (lane >> 5); v[i] = W[(size_t)(k0 + kk) * Nsrc + srccol0 + (lane & 31)]; }
    if (gain) {
#pragma unroll
        for (int i = 0; i < 32; ++i) v[i] *= gain[k0 + 2 * i + (lane >> 5)]; }
#pragma unroll
    for (int i = 0; i < 32; ++i) scr[(2 * i + (lane >> 5)) * 33 + (lane & 31)] = v[i];
    asm volatile("s_waitcnt lgkmcnt(0)" ::: "memory");
    const int c = lane & 7;
#pragma unroll
    for (int j = 0; j < 4; ++j) { const int n = (lane >> 3) + 8 * j; const LAS float* s = scr + (8 * c) * 33 + n;
        u32x4 o; o.x = pk2(s[0 * 33], s[1 * 33]); o.y = pk2(s[2 * 33], s[3 * 33]); o.z = pk2(s[4 * 33], s[5 * 33]); o.w = pk2(s[6 * 33], s[7 * 33]);
        *(u32x4*)(WT + (size_t)(dstrow0 + n) * K + k0 + 8 * c) = o; }
    asm volatile("s_waitcnt lgkmcnt(0)" ::: "memory");
}
__device__ __forceinline__ int map_col(int kind, int n, int Fh) {
    if (kind == 1) { const int pn = n >> 8, half = (n >> 7) & 1, j = n & 127; return half * Fh + 128 * pn + j; }
    if (kind == 2) { const int pn = n >> 8, pos = n & 255, bj = pos >> 7, wc = (pos >> 5) & 3, i = pos & 31; return 256 * pn + 64 * wc + 32 * bj + i; }
    return n;
}

constexpr int KP = 72, VP = 68;
constexpr int SLOT_BYTES = 64 * KP * 2 + 64 * VP * 2, NSLOT = 7;
__device__ __forceinline__ void attn_phase(LAS unsigned char* lds, const bf16_t* Q, const bf16_t* Kb, const bf16_t* Vt, bf16_t* O, int G, int c) {
    LAS int* flags = (LAS int*)(lds + NSLOT * SLOT_BYTES);
    int tid_ = threadIdx.x; asm volatile("" : "+v"(tid_));
    const int tid = tid_, w = __builtin_amdgcn_readfirstlane(tid >> 6), lane = tid & 63, hf = lane >> 5, n = lane & 31;
    const int lrow = tid >> 3, lch = tid & 7;
#define ATT_KS(t) ((LAS bf16_t*)(lds + ((t) % NSLOT) * SLOT_BYTES))
#define ATT_VS(t) ((LAS bf16_t*)(lds + ((t) % NSLOT) * SLOT_BYTES + 64 * KP * 2))
#define ATT_WRITE(t, kr, vr) do { *(LAS u32x4*)(ATT_KS(t) + lrow * KP + 8 * lch) = kr; LAS u32x2* vp_ = (LAS u32x2*)(ATT_VS(t) + lrow * VP + 8 * lch); u32x2 lo_, hi_; lo_.x = vr.x; lo_.y = vr.y; hi_.x = vr.z; hi_.y = vr.w; vp_[0] = lo_; vp_[1] = hi_; } while (0)
    const int cx = (G % 8 == 0) ? (c & 7) * (G >> 3) + (c >> 3) : c;
    u32x4 pkr[6], pvr[6]; bf16x8 pqf[4];
#define ATT_PREFETCH(uix) do { const int qb_ = (uix) & 7, bh_ = (uix) >> 3, b_ = bh_ >> 4, h_ = bh_ & 15, kb_ = (qb_ * 256) >> 6; const size_t t0_ = (size_t)b_ * SEQ; \
        const bf16_t* kg_ = Kb + (t0_ + lrow) * D + h_ * 64 + 8 * lch; const bf16_t* vg_ = Vt + (size_t)(h_ * 64 + lrow) * M + t0_ + 8 * lch; \
        _Pragma("unroll") for (int i_ = 0; i_ < 6; ++i_) { const int t_ = kb_ - 2 + i_; if (t_ >= 0) { pkr[i_] = *(const u32x4*)(kg_ + (size_t)t_ * 64 * D); pvr[i_] = *(const u32x4*)(vg_ + t_ * 64); } } \
        _Pragma("unroll") for (int ds_ = 0; ds_ < 4; ++ds_) pqf[ds_] = *(const bf16x8*)(Q + (t0_ + qb_ * 256 + 32 * w + n) * D + h_ * 64 + 16 * ds_ + 8 * hf); } while (0)
#pragma unroll
    for (int i = 0; i < 6; ++i) { pkr[i] = (u32x4){0, 0, 0, 0}; pvr[i] = (u32x4){0, 0, 0, 0}; }
    if (cx < BATCH * 16 * 8) ATT_PREFETCH(cx);
    for (int ui = cx; ui < BATCH * 16 * 8; ui += G) {
        const int qb = ui & 7, bh = ui >> 3, b = bh >> 4, h = bh & 15, q0 = qb * 256;
        const size_t tok0 = (size_t)b * SEQ;
        const int qpos = q0 + 32 * w + n, kbase = q0 >> 6, kd = kbase + (w >> 1);
        bf16x8 qf[4];
#pragma unroll
        for (int ds = 0; ds < 4; ++ds) qf[ds] = pqf[ds];
        f32x16 o0, o1;
#pragma unroll
        for (int i = 0; i < 16; ++i) { o0[i] = 0.f; o1[i] = 0.f; }
        float carry = 1.0f; bool wdone = false;
        if (tid < 8) flags[tid] = 0;
        const bf16_t* kg = Kb + (tok0 + lrow) * D + h * 64 + 8 * lch;
        const bf16_t* vg = Vt + (size_t)(h * 64 + lrow) * M + tok0 + 8 * lch;
#pragma unroll
        for (int i = 0; i < 6; ++i) { const int t_ = kbase - 2 + i; if (t_ >= 0) ATT_WRITE(t_, pkr[i], pvr[i]); }
        if (ui + G < BATCH * 16 * 8) ATT_PREFETCH(ui + G);
        __syncthreads();
        for (int s = 0;; ++s) {
            if (s >= 3) {
                const int tn = kbase - s;
                if (tn >= 0) { const u32x4 kr_ = *(const u32x4*)(kg + (size_t)tn * 64 * D), vr_ = *(const u32x4*)(vg + tn * 64); ATT_WRITE(tn, kr_, vr_); }
                __syncthreads(); }
            const int t = kd - s;
            if (t < 0) wdone = true;
            if (!wdone) {
                const LAS bf16_t* Ks = ATT_KS(t); const LAS bf16_t* Vs = ATT_VS(t);
                f32x16 s0, s1;
#pragma unroll
                for (int i = 0; i < 16; ++i) { s0[i] = 0.f; s1[i] = 0.f; }
                const bool diag = (s == 0);
                const bool hi_ok = !(diag && ((w & 1) == 0));
#pragma unroll
                for (int ds = 0; ds < 4; ++ds) {
                    const bf16x8 ka0 = *(const LAS bf16x8*)(Ks + n * KP + 16 * ds + 8 * hf);
                    s0 = __builtin_amdgcn_mfma_f32_32x32x16_bf16(ka0, qf[ds], s0, 0, 0, 0); }
                if (hi_ok) {
#pragma unroll
                    for (int ds = 0; ds < 4; ++ds) { const bf16x8 ka1 = *(const LAS bf16x8*)(Ks + (32 + n) * KP + 16 * ds + 8 * hf);
                        s1 = __builtin_amdgcn_mfma_f32_32x32x16_bf16(ka1, qf[ds], s1, 0, 0, 0); } }
                f32x2 E[2][2][4], I[2][2][4], W[2][2][4]; float tot[8], ptot[8], exg[8];
#define ATT_S(kb, r) ((kb) ? s1[r] : s0[r])
#define ATT_EXP(kb) _Pragma("unroll") for (int pi = 0; pi < 2; ++pi) _Pragma("unroll") for (int j = 0; j < 4; ++j) { \
                        E[kb][pi][j].x = __builtin_amdgcn_exp2f(__builtin_amdgcn_fmed3f(ATT_S(kb, 8 * pi + j), -126.0f, 30.0f)); E[kb][pi][j].y = __builtin_amdgcn_exp2f(__builtin_amdgcn_fmed3f(ATT_S(kb, 8 * pi + 4 + j), -126.0f, 30.0f)); }
#define ATT_MASK(kb) _Pragma("unroll") for (int pi = 0; pi < 2; ++pi) _Pragma("unroll") for (int j = 0; j < 4; ++j) { const int key_ = 64 * t + 32 * kb + 16 * pi + 4 * hf + j; \
                        E[kb][pi][j].x = (key_ >= qpos) ? 0.0f : E[kb][pi][j].x; E[kb][pi][j].y = (key_ + 8 >= qpos) ? 0.0f : E[kb][pi][j].y; }
#define ATT_GROUPS(kb) _Pragma("unroll") for (int pi = 0; pi < 2; ++pi) { const f32x2 d0 = E[kb][pi][0] + 1.0f, d1 = E[kb][pi][1] + 1.0f, d2 = E[kb][pi][2] + 1.0f, d3 = E[kb][pi][3] + 1.0f; \
                        const f32x2 b01 = d0 * d1, c012 = b01 * d2, dd = c012 * d3; f32x2 R; R.x = __builtin_amdgcn_rcpf(dd.x); R.y = __builtin_amdgcn_rcpf(dd.y); \
                        I[kb][pi][0] = R; I[kb][pi][1] = R * d0; I[kb][pi][2] = R * b01; I[kb][pi][3] = R * c012; tot[4 * kb + 2 * pi] = R.x; tot[4 * kb + 2 * pi + 1] = R.y; }
#define ATT_WEIGHTS(kb) _Pragma("unroll") for (int pi = 0; pi < 2; ++pi) { const f32x2 ex2 = (f32x2){exg[4 * kb + 2 * pi], exg[4 * kb + 2 * pi + 1]}; \
                        _Pragma("unroll") for (int j = 0; j < 4; ++j) W[kb][pi][j] = E[kb][pi][j] * (ex2 * I[kb][pi][j]); }
                ATT_EXP(0)
                if (hi_ok) { ATT_EXP(1) }
                if (diag) { if (w & 1) { ATT_MASK(1) } else { ATT_MASK(0) } }
                ATT_GROUPS(0)
                if (hi_ok) { ATT_GROUPS(1) }
                else {
#pragma unroll
                    for (int i = 0; i < 4; ++i) tot[4 + i] = 1.0f; }
#pragma unroll
                for (int i = 0; i < 4; ++i) ptot[i] = __shfl_xor(tot[i], 32);
                if (hi_ok) {
#pragma unroll
                    for (int i = 4; i < 8; ++i) ptot[i] = __shfl_xor(tot[i], 32); }
                else {
#pragma unroll
                    for (int i = 4; i < 8; ++i) ptot[i] = 1.0f; }
                float run = carry;
#pragma unroll
                for (int idx = 7; idx >= 0; --idx) { if (idx >= 4 && !hi_ok) continue;
                    const float a = hf ? 1.0f : ptot[idx]; exg[idx] = run * a; run = (run * tot[idx]) * ptot[idx]; }
                ATT_WEIGHTS(0)
                if (hi_ok) { ATT_WEIGHTS(1) }
#undef ATT_S
#undef ATT_EXP
#undef ATT_MASK
#undef ATT_GROUPS
#undef ATT_WEIGHTS
                carry = run;
#pragma unroll
                for (int kb = 0; kb < 2; ++kb) { if (kb == 1 && !hi_ok) continue;
#pragma unroll
                    for (int s2 = 0; s2 < 2; ++s2) {
                        union { u32x4 u; bf16x8 v; } pf;
                        pf.u.x = cvt_pk_bf16(W[kb][s2][0].x, W[kb][s2][1].x); pf.u.y = cvt_pk_bf16(W[kb][s2][2].x, W[kb][s2][3].x);
                        pf.u.z = cvt_pk_bf16(W[kb][s2][0].y, W[kb][s2][1].y); pf.u.w = cvt_pk_bf16(W[kb][s2][2].y, W[kb][s2][3].y);
#pragma unroll
                        for (int db = 0; db < 2; ++db) {
                            const LAS bf16_t* vp = Vs + (32 * db + n) * VP + 32 * kb + 16 * s2 + 4 * hf;
                            union { u32x4 u; bf16x8 v; } vf; const u32x2 lo = *(const LAS u32x2*)vp, hi = *(const LAS u32x2*)(vp + 8);
                            vf.u.x = lo.x; vf.u.y = lo.y; vf.u.z = hi.x; vf.u.w = hi.y;
                            if (db == 0) o0 = __builtin_amdgcn_mfma_f32_32x32x16_bf16(vf.v, pf.v, o0, 0, 0, 0); else o1 = __builtin_amdgcn_mfma_f32_32x32x16_bf16(vf.v, pf.v, o1, 0, 0, 0); } } }
                wdone = (__ballot(carry >= 1e-15f) == 0ull);
            }
            if (s >= 1) {
                if (lane == 0) flags[w] = wdone ? 1 : 0;
                __syncthreads();
                int all = 1;
#pragma unroll
                for (int i = 0; i < 8; ++i) all &= flags[i];
                if (all) break; }
        }
        { LAS bf16_t* Os = (LAS bf16_t*)(lds + w * (32 * 72 * 2));
#pragma unroll
          for (int i = 0; i < 4; ++i) { u32x2 a, bq; a.x = cvt_pk_bf16(o0[4 * i], o0[4 * i + 1]); a.y = cvt_pk_bf16(o0[4 * i + 2], o0[4 * i + 3]); bq.x = cvt_pk_bf16(o1[4 * i], o1[4 * i + 1]); bq.y = cvt_pk_bf16(o1[4 * i + 2], o1[4 * i + 3]);
              *(LAS u32x2*)(Os + n * 72 + 8 * i + 4 * hf) = a; *(LAS u32x2*)(Os + n * 72 + 32 + 8 * i + 4 * hf) = bq; }
          asm volatile("s_waitcnt lgkmcnt(0)" ::: "memory");
          const int orow = lane >> 3, och = lane & 7;
#pragma unroll
          for (int k = 0; k < 4; ++k) { const u32x4 v = *(const LAS u32x4*)(Os + (8 * k + orow) * 72 + 8 * och);
              *(u32x4*)(O + (tok0 + q0 + 32 * w + 8 * k + orow) * D + h * 64 + 8 * och) = v; } }
        __syncthreads();
    }
#undef ATT_KS
#undef ATT_VS
#undef ATT_WRITE
#undef ATT_PREFETCH
}

#define XB_TMO      128
#define XB_XCNT(j)  (256  + 64 * (j))
#define XB_XSUB(j)  (1280 + 64 * (j))
#define XB_XGEN(j)  (2304 + 64 * (j))
#define XB_TOP      3328
#define XB_TOPGEN   3392
#define XCD_BAR_WORDS 3456
#define XB_SPIN_CAP (1u << 20)
__device__ __forceinline__ unsigned xb_ld(unsigned* p)              { return __hip_atomic_load(p, __ATOMIC_RELAXED, __HIP_MEMORY_SCOPE_AGENT); }
__device__ __forceinline__ unsigned xb_add(unsigned* p, unsigned v) { return __hip_atomic_fetch_add(p, v, __ATOMIC_RELAXED, __HIP_MEMORY_SCOPE_AGENT); }
__device__ __forceinline__ unsigned xb_xcc_id() { return (unsigned)__builtin_amdgcn_s_getreg((3 << 11) | 20) & 0xFu; }
#define XB_SPIN(cond, bar) do { unsigned _sp = 0; while (cond) { __builtin_amdgcn_s_sleep(1); \
    if ((++_sp & 255u) == 0u) { if (xb_ld(&(bar)[XB_TMO])) break; if (_sp > XB_SPIN_CAP) { atomicAdd(&(bar)[XB_TMO], 1u); break; } } } } while (0)
struct XcdBarrier { unsigned* bar; unsigned x; volatile LAS unsigned* st; };
__device__ __forceinline__ unsigned xcd_barrier_post(unsigned* bar, unsigned x) { return xb_add(&bar[XB_XCNT(x)], 1u); }
__device__ __forceinline__ void xcd_barrier_complete(unsigned* bar, unsigned x, unsigned& nloc, unsigned& nx) {
    const unsigned G = gridDim.x * gridDim.y * gridDim.z;
    unsigned sum, cnt, mine, sp = 0u;
    for (;;) {
        sum = 0u; cnt = 0u; mine = 0u;
#pragma unroll
        for (unsigned j = 0; j < 16; ++j) { const unsigned c = xb_ld(&bar[XB_XCNT(j)]); sum += c; cnt += (c > 0u) ? 1u : 0u; mine = (j == x) ? c : mine; }
        if (sum == G) break;
        __builtin_amdgcn_s_sleep(1);
        if ((++sp & 255u) == 0u) { if (xb_ld(&bar[XB_TMO])) break; if (sp > XB_SPIN_CAP) { atomicAdd(&bar[XB_TMO], 1u); break; } }
    }
    nloc = mine > 0u ? mine : 1u; nx = cnt > 0u ? cnt : 1u;
}
__device__ __forceinline__ void xcd_barrier(const XcdBarrier& b) {
    asm volatile("s_waitcnt vmcnt(0)" ::: "memory");
    __syncthreads();
    if (threadIdx.x == 0) {
        unsigned* bar = b.bar;
        __builtin_amdgcn_s_waitcnt(0);
        unsigned nloc = b.st[0], nx = b.st[1];
        if (nloc == 0u) { xcd_barrier_complete(bar, b.x, nloc, nx); b.st[0] = nloc; b.st[1] = nx; }
        const unsigned old = xb_add(&bar[XB_XSUB(b.x)], 1u);
        const unsigned gen = old / nloc;
        if (old + 1u == (gen + 1u) * nloc) {
            __builtin_amdgcn_fence(__ATOMIC_RELEASE, "agent");
            asm volatile("s_waitcnt vmcnt(0)" ::: "memory");
            const unsigned og = xb_add(&bar[XB_TOP], 1u);
            const unsigned tg = og / nx;
            if (og + 1u == (tg + 1u) * nx) xb_add(&bar[XB_TOPGEN], 1u);
            else XB_SPIN(xb_ld(&bar[XB_TOPGEN]) == tg, bar);
            __builtin_amdgcn_fence(__ATOMIC_ACQUIRE, "agent");
            xb_add(&bar[XB_XGEN(b.x)], 1u);
            asm volatile("s_waitcnt vmcnt(0)" ::: "memory");
        } else {
            XB_SPIN(xb_ld(&bar[XB_XGEN(b.x)]) == gen, bar);
            __builtin_amdgcn_fence(__ATOMIC_ACQUIRE, "agent");
            asm volatile("s_waitcnt vmcnt(0)" ::: "memory");
        }
    }
    __syncthreads();
}
constexpr int LDS_VCU = 131072 + 128;
constexpr int LDS_BARST = 131072 + 64;
constexpr size_t WS_BAR = 16384;

struct Args { const float* in[24]; float* out; unsigned char* ws; };
#define CAS __attribute__((address_space(4)))
__device__ __forceinline__ const CAS Args* fresh_args() { const CAS Args* p = (const CAS Args*)__builtin_amdgcn_kernarg_segment_ptr(); asm volatile("" : "+s"(p)); return p; }
#define WSP(T, off) ((T*)(ws + (off)))
#define GRID_BAR() do { const CAS Args* A_ = fresh_args(); XcdBarrier b_; b_.bar = (unsigned*)(A_->ws + WS_BAR); b_.x = xb_xcc_id(); b_.st = (volatile LAS unsigned*)(lds + LDS_BARST); xcd_barrier(b_); } while (0)
__global__ void __launch_bounds__(512, 2) yoco_fwd(Args a_unused) {
    extern __shared__ __attribute__((aligned(16))) unsigned char lds_raw[];
    LAS unsigned char* lds = (LAS unsigned char*)lds_raw;
    cg::grid_group grid = cg::this_grid();
    if (threadIdx.x < 2) ((LAS unsigned*)(lds + LDS_BARST))[threadIdx.x] = 0u;
    if (blockIdx.x == 0) { const CAS Args* A_ = fresh_args(); unsigned* bar_ = (unsigned*)(A_->ws + WS_BAR); for (int i = threadIdx.x; i < XCD_BAR_WORDS; i += 512) bar_[i] = 0u; }
    __syncthreads();

    {
        const CAS Args* A = fresh_args(); unsigned char* ws = A->ws;
        int tid_ = threadIdx.x; asm volatile("" : "+v"(tid_));
        const int tid = tid_, lane = tid & 63, wave = __builtin_amdgcn_readfirstlane(tid >> 6), G = gridDim.x, bx = blockIdx.x;
        for (int gq = bx; gq < NG * 4; gq += G) p0_ssm_consts(gq >> 2, gq & 3, A->in[3], A->in[4], A->in[5], A->in[6], A->in[7], A->in[8], A->in[10], WSP(bf16_t, WS_TOEP), WSP(bf16_t, WS_WST), WSP(float, WS_AT), (LAS float*)lds, tid);
        const int gw = bx * 8 + wave, NGW = G * 8;
        LAS float* scr = (LAS float*)(lds + wave * 16384);
        for (int it = gw; it < 12032; it += NGW) {
            int r = it; const float* W; const float* gain = nullptr; bf16_t* dst; int K = 1024, Nsrc, Ndst, kind = 0, Fh = 0, base = 0;
            if (r < 512) { W = A->in[2]; gain = A->in[1]; dst = WSP(bf16_t, WS_WIN); Nsrc = 1024; Ndst = 1024; }
            else if ((r -= 512) < 1024) { W = A->in[11]; dst = WSP(bf16_t, WS_WGLU); Nsrc = 2048; Ndst = 2048; kind = 1; Fh = 1024; }
            else if ((r -= 1024) < 512) { W = A->in[16]; gain = A->in[15]; dst = WSP(bf16_t, WS_WQKV); Nsrc = 1024; Ndst = 1024; kind = 2; }
            else if ((r -= 512) < 512) { W = A->in[13]; gain = A->in[12]; dst = WSP(bf16_t, WS_WQKV) + (size_t)1024 * 1024; Nsrc = 2048; Ndst = 1024; kind = 2; }
            else if ((r -= 512) < 512) { W = A->in[13]; gain = A->in[12]; dst = WSP(bf16_t, WS_WQKV) + (size_t)2048 * 1024; Nsrc = 2048; Ndst = 1024; kind = 0; base = 1024; }
            else if ((r -= 512) < 512) { W = A->in[18]; dst = WSP(bf16_t, WS_WO); Nsrc = 1024; Ndst = 1024; }
            else if ((r -= 512) < 2816) { W = A->in[20]; gain = A->in[19]; dst = WSP(bf16_t, WS_UP0); Nsrc = 2 * FF; Ndst = 2 * FF; kind = 1; Fh = FF; }
            else if ((r -= 2816) < 2816) { W = A->in[20] + (size_t)D * 2 * FF; gain = A->in[19] + D; dst = WSP(bf16_t, WS_UP1); Nsrc = 2 * FF; Ndst = 2 * FF; kind = 1; Fh = FF; }
            else if ((r -= 2816) < 1408) { W = A->in[23]; dst = WSP(bf16_t, WS_DN0); K = FF; Nsrc = 1024; Ndst = 1024; }
            else { r -= 1408; W = A->in[23] + (size_t)FF * D; dst = WSP(bf16_t, WS_DN1); K = FF; Nsrc = 1024; Ndst = 1024; }
            const int nblk = Ndst / 32, kb = r / nblk, nb = r % nblk;
            p0_transpose_item(W, K, Nsrc, gain, dst, 64 * kb, base + map_col(kind, 32 * nb, Fh), 32 * nb, scr, lane);
        }
        const float* x = A->in[0]; float* rstd0 = WSP(float, WS_RSTD0); bf16_t* XB = WSP(bf16_t, WS_XB);
        for (int m = gw; m < M; m += 4 * NGW) {
            f32x4 v[4][4]; float sq[4];
#pragma unroll
            for (int r = 0; r < 4; ++r) { const f32x4* xr = (const f32x4*)(x + (size_t)(m + r * NGW) * D) + lane;
#pragma unroll
                for (int j = 0; j < 4; ++j) v[r][j] = xr[64 * j]; }
#pragma unroll
            for (int r = 0; r < 4; ++r) { float q = 0.f;
#pragma unroll
                for (int j = 0; j < 4; ++j) q += (v[r][j][0] * v[r][j][0] + v[r][j][1] * v[r][j][1]) + (v[r][j][2] * v[r][j][2] + v[r][j][3] * v[r][j][3]);
                sq[r] = wave_sum(q); }
#pragma unroll
            for (int r = 0; r < 4; ++r) { if (lane == 0) rstd0[m + r * NGW] = 1.0f / sqrtf(sq[r] * (1.0f / D) + EPS);
                u32x2* o8 = (u32x2*)(XB + (size_t)(m + r * NGW) * D) + lane;
#pragma unroll
                for (int j = 0; j < 4; ++j) { u32x2 w; w.x = pk2(v[r][j][0], v[r][j][1]); w.y = pk2(v[r][j][2], v[r][j][3]); o8[64 * j] = w; } }
        }
        float* ss1 = WSP(float, WS_SS1);
        for (int i = bx * 512 + tid; i < 3 * M; i += G * 512) ss1[i] = 0.f;
    }
    grid.sync();
    if (threadIdx.x == 0) {
        const CAS Args* A_ = fresh_args(); unsigned* bar_ = (unsigned*)(A_->ws + WS_BAR); const unsigned x_ = xb_xcc_id(); const unsigned rk_ = xcd_barrier_post(bar_, x_);
        unsigned nloc_, nx_; xcd_barrier_complete(bar_, x_, nloc_, nx_);
        ((volatile LAS unsigned*)(lds + LDS_BARST))[0] = nloc_; ((volatile LAS unsigned*)(lds + LDS_BARST))[1] = nx_;
        bool ok_ = (gridDim.x % 8u) == 0u;
        for (unsigned j = 0; j < 16; ++j) { const unsigned cnt_ = xb_ld(&bar_[XB_XCNT(j)]); ok_ = ok_ && (cnt_ == (j < 8u ? gridDim.x / 8u : 0u)); }
        ((LAS unsigned*)(lds + LDS_VCU))[0] = ok_ ? rk_ * 8u + x_ : blockIdx.x; }
    __syncthreads();
#define VCU() ((int)__builtin_amdgcn_readfirstlane(((volatile LAS unsigned*)(lds + LDS_VCU))[0]))


    { const CAS Args* A = fresh_args(); unsigned char* ws = A->ws; pg8::StaticOrder S;
      pg8::Gemm g{WSP(bf16_t, WS_XB), WSP(bf16_t, WS_WIN), M, D, D, 2 * D, 32, 0}; S.init(M, D, gridDim.x, VCU()); EpiU E{WSP(float, WS_RSTD0), WSP(bf16_t, WS_UBUF)}; pg8::gemm_phase(lds, g, S, E); }
    GRID_BAR();
    { const CAS Args* A = fresh_args(); unsigned char* ws = A->ws; pg8::StaticOrder S;
      pg8::Gemm g{WSP(bf16_t, WS_UBUF), WSP(bf16_t, WS_WST), NG * 2048, 256, 512, 2 * UP, 32, (size_t)256 * 512 * 2}; S.init(NG * 2048, 256, gridDim.x, VCU()); EpiSloc E{WSP(float, WS_SLOC)}; pg8::gemm_phase(lds, g, S, E); }
    GRID_BAR();
    { const CAS Args* A = fresh_args(); unsigned char* ws = A->ws; const float* AT = WSP(float, WS_AT); const float* SLOC = WSP(float, WS_SLOC); bf16_t* UBUF = WSP(bf16_t, WS_UBUF);
      int tid_ = threadIdx.x; asm volatile("" : "+v"(tid_));
      for (int gid = blockIdx.x * 512 + tid_; gid < NG * BATCH * 64; gid += gridDim.x * 512) {
        const int p = gid & 63, b = (gid >> 6) & 31, g = gid >> 11; const float ar = AT[(g * 64 + p) * 2], ai = AT[(g * 64 + p) * 2 + 1];
        float hr = 0.f, hi = 0.f; const size_t r0 = (size_t)g * 2048 + b * 64;
        for (int c0 = 0; c0 < NCH; c0 += 8) { float sr[8], si[8];
#pragma unroll
            for (int k = 0; k < 8; ++k) { sr[k] = SLOC[(r0 + c0 + k) * 128 + p]; si[k] = SLOC[(r0 + c0 + k) * 128 + 64 + p]; }
#pragma unroll
            for (int k = 0; k < 8; ++k) { bf16_t* up = UBUF + (r0 + c0 + k) * UP + 512 + p; up[0] = (bf16_t)f2bf(hr); up[64] = (bf16_t)f2bf(hi);
                const float nr = ar * hr - ai * hi + sr[k], ni = ar * hi + ai * hr + si[k]; hr = nr; hi = ni; } }
      } }
    GRID_BAR();
    { const CAS Args* A = fresh_args(); unsigned char* ws = A->ws; pg8::StaticOrder S;
      pg8::Gemm g{WSP(bf16_t, WS_UBUF), WSP(bf16_t, WS_TOEP), NG * 2048, 512, UP, 2 * UP, 32, (size_t)512 * UP * 2}; S.init(NG * 2048, 512, gridDim.x, VCU());
      EpiSsmOut E{WSP(bf16_t, WS_UBUF), A->in[9], WSP(bf16_t, WS_GBUF)}; pg8::gemm_phase(lds, g, S, E); }
    GRID_BAR();
    { const CAS Args* A = fresh_args(); unsigned char* ws = A->ws; pg8::StaticOrder S;
      pg8::Gemm g{WSP(bf16_t, WS_GBUF), WSP(bf16_t, WS_WGLU), M, 2 * D, D, 32, (unsigned)((size_t)M * 16 * 2), 0}; S.init(M, 2 * D, gridDim.x, VCU());
      EpiGlu E{WSP(bf16_t, WS_XB), WSP(bf16_t, WS_HB), WSP(float, WS_SS1)}; pg8::gemm_phase(lds, g, S, E); }
    GRID_BAR();
#pragma unroll 1
    for (int layer = 0; layer < 2; ++layer) {
        if (layer == 1) {
            { const CAS Args* A = fresh_args(); unsigned char* ws = A->ws; pg8::StaticOrder S;
              pg8::Gemm g{WSP(bf16_t, WS_HB), WSP(bf16_t, WS_WQKV), M, 2 * D, D, 2 * D, 32, 0}; S.init(M, 2 * D, gridDim.x, VCU());
              EpiQkv E{WSP(float, WS_SS2), A->in[17], A->in[14], WSP(bf16_t, WS_Q), WSP(bf16_t, WS_K)}; pg8::gemm_phase(lds, g, S, E); }
            { const CAS Args* A = fresh_args(); unsigned char* ws = A->ws; pg8::StaticOrder S;
              pg8::Gemm g{WSP(bf16_t, WS_WQKV) + (size_t)2048 * 1024, WSP(bf16_t, WS_HB), D, M, D, 2 * D, 32, 0}; S.init(D, M, gridDim.x, VCU());
              EpiVt E{WSP(float, WS_SS2), WSP(bf16_t, WS_V)}; pg8::gemm_phase(lds, g, S, E); }
            GRID_BAR();
            { const CAS Args* A = fresh_args(); unsigned char* ws = A->ws; attn_phase(lds, WSP(bf16_t, WS_Q), WSP(bf16_t, WS_K), WSP(bf16_t, WS_V), WSP(bf16_t, WS_O), gridDim.x, VCU()); }
            GRID_BAR();
            { const CAS Args* A = fresh_args(); unsigned char* ws = A->ws; pg8::StaticOrder S;
              pg8::Gemm g{WSP(bf16_t, WS_O), WSP(bf16_t, WS_WO), M, D, D, 2 * D, 32, 0}; S.init(M, D, gridDim.x, VCU()); EpiResid<false> E{nullptr, WSP(bf16_t, WS_HB), WSP(float, WS_SS3)}; pg8::gemm_phase(lds, g, S, E); }
            GRID_BAR();
        }
        { const CAS Args* A = fresh_args(); unsigned char* ws = A->ws; pg8::StaticOrder S;
          pg8::Gemm g{WSP(bf16_t, WS_HB), WSP(bf16_t, WS_UP0 + (size_t)layer * (WS_UP1 - WS_UP0)), M, 2 * FF, D, 2 * D, 32, 0}; S.init(M, 2 * FF, gridDim.x, VCU());
          EpiUp E{WSP(float, WS_SS1 + (size_t)layer * (WS_SS3 - WS_SS1)), A->in[21] + (size_t)layer * 3 * FF, A->in[22] + (size_t)layer * FF, WSP(bf16_t, WS_ACT), WSP(bf16_t, WS_BNDG)}; pg8::gemm_phase(lds, g, S, E); }
        GRID_BAR();
        { const CAS Args* A = fresh_args(); unsigned char* ws = A->ws; const float* cw = A->in[21] + (size_t)layer * 3 * FF; const float* cb = A->in[22] + (size_t)layer * FF;
          const bf16_t* BNDG = WSP(bf16_t, WS_BNDG); bf16_t* ACT = WSP(bf16_t, WS_ACT);
          int tid_ = threadIdx.x; asm volatile("" : "+v"(tid_));
          for (int i = blockIdx.x * 512 + tid_; i < 1024 * 2 * (FF / 8); i += gridDim.x * 512) { const int c8 = i % (FF / 8), r = (i / (FF / 8)) & 1, k = i / (2 * (FF / 8)); const int ch = 8 * c8;
            const u32x4 zero = (u32x4){0, 0, 0, 0}; const bool first = (k & 31) == 0;
            const u32x4 qm2 = first ? zero : *(const u32x4*)(BNDG + ((size_t)(k - 1) * 4 + 0) * FF + ch), qm1 = first ? zero : *(const u32x4*)(BNDG + ((size_t)(k - 1) * 4 + 1) * FF + ch);
            const u32x4 q0 = *(const u32x4*)(BNDG + ((size_t)k * 4 + 2) * FF + ch), q1 = *(const u32x4*)(BNDG + ((size_t)k * 4 + 3) * FF + ch);
            bf16_t* ap = ACT + ((size_t)k * 64 + r) * FF + ch; const u32x4 qv = *(const u32x4*)ap;
            const u32x4 ta = r == 0 ? qm2 : qm1, tb = r == 0 ? qm1 : q0, tc = r == 0 ? q0 : q1;
            float res[8];
#pragma unroll
            for (int e = 0; e < 8; ++e) { const unsigned wa = e < 2 ? ta.x : e < 4 ? ta.y : e < 6 ? ta.z : ta.w, wb = e < 2 ? tb.x : e < 4 ? tb.y : e < 6 ? tb.z : tb.w, wc_ = e < 2 ? tc.x : e < 4 ? tc.y : e < 6 ? tc.z : tc.w, wv = e < 2 ? qv.x : e < 4 ? qv.y : e < 6 ? qv.z : qv.w;
                const float fa = (e & 1) ? bf_hi(wa) : bf_lo(wa), fb = (e & 1) ? bf_hi(wb) : bf_lo(wb), fc = (e & 1) ? bf_hi(wc_) : bf_lo(wc_), fv = (e & 1) ? bf_hi(wv) : bf_lo(wv);
                const float gc = cb[ch + e] + cw[ch + e] * fa + cw[FF + ch + e] * fb + cw[2 * FF + ch + e] * fc;
                res[e] = gc * sigmoidf_(gc) * fv; }
            u32x4 w; w.x = pk2(res[0], res[1]); w.y = pk2(res[2], res[3]); w.z = pk2(res[4], res[5]); w.w = pk2(res[6], res[7]);
            *(u32x4*)ap = w; } }
        GRID_BAR();
        if (layer == 0) { { const CAS Args* A = fresh_args(); unsigned char* ws = A->ws; pg8::StaticOrder S;
            pg8::Gemm g{WSP(bf16_t, WS_ACT), WSP(bf16_t, WS_DN0), M, D, FF, 2 * FF, 32, 0}; S.init(M, D, gridDim.x, VCU()); EpiResid<false> E{nullptr, WSP(bf16_t, WS_HB), WSP(float, WS_SS2)}; pg8::gemm_phase(lds, g, S, E); }
            GRID_BAR(); }
        else { const CAS Args* A = fresh_args(); unsigned char* ws = A->ws; pg8::StaticOrder S;
            pg8::Gemm g{WSP(bf16_t, WS_ACT), WSP(bf16_t, WS_DN1), M, D, FF, 2 * FF, 32, 0}; S.init(M, D, gridDim.x, VCU()); EpiResid<true> E{A->out, WSP(bf16_t, WS_HB), nullptr}; pg8::gemm_phase(lds, g, S, E); }
    }
}

extern "C" void kernel_launch(void* const* d_in, const int* in_sizes, int n_in, void* d_out, int out_size, void* d_ws, size_t ws_size, hipStream_t stream) {
    static int grid = 0;
    if (grid == 0) {
        if (n_in != 24 || in_sizes[0] != M * D || out_size != M * D || ws_size < WS_END) { fprintf(stderr, "kernel_launch: unexpected shapes (n_in %d, in0 %d, out %d, ws %zu)\n", n_in, n_in > 0 ? in_sizes[0] : -1, out_size, ws_size); grid = -1; return; }
        int dev = 0, cus = 0, per_cu = 0;
        hipGetDevice(&dev); hipDeviceGetAttribute(&cus, hipDeviceAttributeMultiprocessorCount, dev);
        if (hipFuncSetAttribute((const void*)yoco_fwd, hipFuncAttributeMaxDynamicSharedMemorySize, LDS_BYTES) != hipSuccess) { fprintf(stderr, "kernel_launch: hipFuncSetAttribute failed\n"); grid = -1; return; }
        if (hipOccupancyMaxActiveBlocksPerMultiprocessor(&per_cu, (const void*)yoco_fwd, 512, LDS_BYTES) != hipSuccess || per_cu < 1) { fprintf(stderr, "kernel_launch: occupancy query says %d\n", per_cu); per_cu = 1; }
        (void)hipGetLastError();
        grid = cus;
    }
    if (grid < 0) return;
    Args a{};
    for (int i = 0; i < 24; ++i) a.in[i] = (const float*)d_in[i];
    a.out = (float*)d_out; a.ws = (unsigned char*)d_ws;
    void* args[] = {&a};
    hipError_t e = hipLaunchCooperativeKernel((const void*)yoco_fwd, dim3(grid), dim3(512), args, LDS_BYTES, stream);
    if (e != hipSuccess) fprintf(stderr, "cooperative launch failed: %s (grid %d)\n", hipGetErrorString(e), grid);
}
```

```cpp
#include <hip/hip_runtime.h>
#include <hip/hip_cooperative_groups.h>
#include <cstdio>
#include <cstdint>
namespace cg = cooperative_groups;

#define LAS __attribute__((address_space(3)))
typedef unsigned short bf16_t;
typedef short bf16x8 __attribute__((ext_vector_type(8)));
typedef float f32x4 __attribute__((ext_vector_type(4)));
typedef float f32x16 __attribute__((ext_vector_type(16)));
typedef unsigned u32x4 __attribute__((ext_vector_type(4)));
typedef unsigned u32x2 __attribute__((ext_vector_type(2)));

constexpr int D = 1024, SEQ = 2048, BATCH = 32, M = BATCH * SEQ, FF = 2816, NG = 64, TS = 32  , NCH = SEQ / TS;
constexpr int UP = 640;
constexpr float EPS = 1e-6f;
constexpr size_t MiB = 1u << 20;
constexpr size_t WS_RSTD0 = 1 * MiB, WS_SS1 = WS_RSTD0 + 262144, WS_SS2 = WS_SS1 + 262144, WS_SS3 = WS_SS2 + 262144;
constexpr size_t WS_WIN = 2 * MiB, WS_WGLU = 4 * MiB, WS_WQKV = 8 * MiB, WS_WO = 14 * MiB, WS_UP0 = 16 * MiB, WS_UP1 = 27 * MiB, WS_DN0 = 38 * MiB, WS_DN1 = 44 * MiB;
constexpr size_t WS_TOEP = 50 * MiB, WS_WST = 90 * MiB, WS_AT = 106 * MiB;
constexpr size_t WS_XB = 128 * MiB, WS_GBUF = 480 * MiB  , WS_Q = 128 * MiB;
constexpr size_t WS_UBUF = 256 * MiB, WS_HB = 256 * MiB;
constexpr size_t WS_SLOC = 416 * MiB;
constexpr size_t WS_ACT = 480 * MiB, WS_K = 480 * MiB, WS_V = 608 * MiB, WS_O = 736 * MiB;
constexpr size_t WS_BNDG = 864 * MiB, WS_BNDV = 908 * MiB, WS_END = 930 * MiB;
constexpr int LDS_BYTES = 135168;

__device__ __forceinline__ unsigned f2bf(float f) { unsigned u = __builtin_bit_cast(unsigned, f); return (u + 0x7fffu + ((u >> 16) & 1u)) >> 16; }
__device__ __forceinline__ unsigned pk2(float lo, float hi) { return f2bf(lo) | (f2bf(hi) << 16); }
__device__ __forceinline__ unsigned cvt_pk_bf16(float lo, float hi) { unsigned r; asm volatile("v_cvt_pk_bf16_f32 %0, %1, %2" : "=v"(r) : "v"(lo), "v"(hi)); return r; }
__device__ __forceinline__ float bf_lo(unsigned w) { return __builtin_bit_cast(float, w << 16); }
__device__ __forceinline__ float bf_hi(unsigned w) { return __builtin_bit_cast(float, w & 0xffff0000u); }
__device__ __forceinline__ float sigmoidf_(float y) { return __builtin_amdgcn_rcpf(1.0f + __builtin_amdgcn_exp2f(-1.44269504089f * y)); }
__device__ __forceinline__ float gelu_tanh(float x) { return x * sigmoidf_(1.5957691216f * (x + 0.044715f * x * x * x)); }
template <int CTRL> __device__ __forceinline__ float dppf(float x) { return __builtin_bit_cast(float, __builtin_amdgcn_update_dpp(0, __builtin_bit_cast(int, x), CTRL, 0xf, 0xf, false)); }
__device__ __forceinline__ float wave_sum(float v) {
#pragma unroll
    for (int o = 1; o < 64; o <<= 1) v += __shfl_xor(v, o);
    return v;
}

namespace pg8 {
constexpr int BM = 256, BK = 64, HALF = 128, HTB = HALF * BK * 2, STAGE_BYTES = 8 * HTB, NXCD = 8, WGM = 8;
__host__ __device__ __forceinline__ int lds_byte(int r, int c) { const int st = (r >> 4) * 2 + (c >> 5), rr = r & 15, cc = c & 31, ob = rr * 64 + cc * 2; return st * 1024 + (ob ^ (((ob >> 9) & 1) << 5)); }
__host__ __device__ __forceinline__ void stage_rc(int b, int& R, int& C) { const int st = b / 1024, sb = b % 1024, swz = sb ^ (((sb >> 9) & 1) << 5); R = (st >> 1) * 16 + swz / 64; C = (st & 1) * 32 + (swz % 64) / 2; }
__host__ __device__ __forceinline__ int perm32(int rho) { const int n = rho >> 4, i = rho & 15; return 8 * (i >> 2) + 4 * n + (i & 3); }

struct Unit { int pm, pn; };
struct Gemm { const bf16_t* A; const bf16_t* Bt; int M, N, K; unsigned a_row, a_cg; size_t b_gstride; };

struct StaticOrder {
    int nM, nN, nwg, G, c;
    __device__ void init(int M_, int N_, int G_, int c_) { nM = M_ / BM; nN = N_ / BM; nwg = nM * nN; G = G_; c = c_; }
    __device__ bool next(int i, Unit& u) const {
        const long L = (long)i * G + c; if (L >= nwg) return false;
        int wgid = (int)L; { const int q = nwg / NXCD, r = nwg % NXCD, xcd = wgid % NXCD, off = wgid / NXCD; wgid = (xcd < r ? xcd * (q + 1) : r * (q + 1) + (xcd - r) * q) + off; }
        const int nig = WGM * nN, gid = wgid / nig, fm = gid * WGM, gsz = (nM - fm) < WGM ? (nM - fm) : WGM;
        u.pm = fm + ((wgid % nig) % gsz); u.pn = (wgid % nig) / gsz; return true;
    }
};

template <class Epi>
__device__ __forceinline__ void gemm_phase(LAS unsigned char* lds, const Gemm g, const StaticOrder S, const Epi E) {
    int tid_ = threadIdx.x; asm volatile("" : "+v"(tid_));
    const int tid = tid_, wid = __builtin_amdgcn_readfirstlane(tid >> 6), lane = tid & 63, wr = wid >> 2, wc = wid & 3, fr = lane & 15, fq = lane >> 4;
    const int K = g.K, nt = K / BK;
    unsigned voffA[2], voffB[2];
#pragma unroll
    for (int i = 0; i < 2; ++i) { int R, C; stage_rc(tid * 16 + i * 8192, R, C); const int Rb = Epi::PERM ? ((R & ~31) + perm32(R & 31)) : R;
        const int Ra = Epi::ROWPERM ? ((R & ~63) | ((R & 15) << 2) | ((R >> 4) & 3)) : R;
        voffA[i] = (unsigned)(C >> 4) * g.a_cg + (unsigned)Ra * g.a_row + (unsigned)(C & 15) * 2u; voffB[i] = (unsigned)(Rb * K + C) * 2u; }
    const size_t kstepA = (size_t)g.a_cg * 4, kstepB = (size_t)(BK * 2);
    const size_t hstepA = (size_t)HALF * g.a_row, hstepB = (size_t)HALF * K * 2;
    const size_t tstepA = 2 * hstepA, tstepB = 2 * hstepB;
    const unsigned ldsw = (unsigned)wid * 1024u;
    const int aoff = lds_byte(wr * 64 + fr, fq * 8), boff = lds_byte(wc * 32 + fr, fq * 8);
#define PG8_SA(b, h) (((b) * 2 + (h)) * HTB)
#define PG8_SB(b, h) ((4 + (b) * 2 + (h)) * HTB)
#define PG8_STAGE(bufoff, gbase, voff) do { _Pragma("unroll") for (int _i = 0; _i < 2; ++_i) \
        __builtin_amdgcn_global_load_lds((const unsigned*)((const char*)(gbase) + (voff)[_i]), (LAS unsigned*)(lds + (bufoff) + ldsw + _i * 8192), 16, 0, 0); } while (0)
#define PG8_LDA(dst, b, h) do { _Pragma("unroll") for (int m = 0; m < 4; ++m) _Pragma("unroll") for (int k = 0; k < 2; ++k) dst[m][k] = *(const LAS bf16x8*)(lds + PG8_SA(b, h) + aoff + m * 2048 + k * 1024); } while (0)
#define PG8_LDB(dst, b, h) do { _Pragma("unroll") for (int n = 0; n < 2; ++n) _Pragma("unroll") for (int k = 0; k < 2; ++k) dst[n][k] = *(const LAS bf16x8*)(lds + PG8_SB(b, h) + boff + n * 2048 + k * 1024); } while (0)
#define PG8_MMA(ai, bj, At, Bt) do { __builtin_amdgcn_s_setprio(1); _Pragma("unroll") for (int m = 0; m < 4; ++m) _Pragma("unroll") for (int n = 0; n < 2; ++n) _Pragma("unroll") for (int k = 0; k < 2; ++k) \
        acc[ai][bj][m][n] = __builtin_amdgcn_mfma_f32_16x16x32_bf16(Bt[n][k], At[m][k], acc[ai][bj][m][n], 0, 0, 0); __builtin_amdgcn_s_setprio(0); } while (0)
#define PG8_WAIT_V(n) asm volatile("s_waitcnt vmcnt(" #n ")" ::: "memory")
#define PG8_WAIT_L(n) asm volatile("s_waitcnt lgkmcnt(" #n ")" ::: "memory")
#define PG8_BAR __builtin_amdgcn_s_barrier()
#define PG8_SCHED __builtin_amdgcn_sched_barrier(0)
    Unit cur, nxt; int ui = 0;
    if (!S.next(0, cur)) return;
    f32x4 acc[2][2][4][2];
#pragma unroll
    for (int a = 0; a < 2; ++a)
#pragma unroll
        for (int b = 0; b < 2; ++b)
#pragma unroll
            for (int m = 0; m < 4; ++m)
#pragma unroll
                for (int n = 0; n < 2; ++n) acc[a][b][m][n] = (f32x4){0.f, 0.f, 0.f, 0.f};
    bf16x8 At[4][2], B0[2][2], B1[2][2];
    const char* cA = (const char*)g.A + (size_t)cur.pm * tstepA; const char* cB = (const char*)g.Bt + (size_t)(cur.pm >> 3) * g.b_gstride + (size_t)cur.pn * tstepB;
    PG8_STAGE(PG8_SB(0, 0), cB, voffB); PG8_STAGE(PG8_SB(0, 1), cB + hstepB, voffB); PG8_STAGE(PG8_SA(0, 0), cA, voffA); PG8_STAGE(PG8_SA(0, 1), cA + hstepA, voffA);
    if (wr == 1) PG8_BAR;
    PG8_WAIT_V(2); PG8_BAR;
    PG8_STAGE(PG8_SB(1, 0), cB + kstepB, voffB); PG8_STAGE(PG8_SA(1, 0), cA + kstepA, voffA); PG8_STAGE(PG8_SB(1, 1), cB + hstepB + kstepB, voffB);
    PG8_WAIT_V(6); PG8_BAR;
    for (;;) {
        const bool has_next = S.next(ui + 1, nxt);
        const char* nA = has_next ? (const char*)g.A + (size_t)nxt.pm * tstepA : cA;
        const char* nB = has_next ? (const char*)g.Bt + (size_t)(nxt.pm >> 3) * g.b_gstride + (size_t)nxt.pn * tstepB : cB;
        for (int t = 0; t < nt; t += 2) {
            const bool last = (t == nt - 2);
            const char* a1 = cA + (size_t)(t + 1) * kstepA;
            const char* a2 = last ? nA : cA + (size_t)(t + 2) * kstepA; const char* b2 = last ? nB : cB + (size_t)(t + 2) * kstepB;
            const char* a3 = a2 + kstepA; const char* b3 = b2 + kstepB;
            PG8_LDB(B0, 0, 0); PG8_LDB(B1, 0, 1); PG8_SCHED; PG8_LDA(At, 0, 0); PG8_STAGE(PG8_SA(1, 1), a1 + hstepA, voffA);
            PG8_WAIT_V(8); PG8_WAIT_L(0); PG8_BAR; PG8_MMA(0, 0, At, B0); PG8_MMA(0, 1, At, B1); PG8_BAR; PG8_SCHED;
            PG8_LDA(At, 0, 1); PG8_STAGE(PG8_SB(0, 0), b2, voffB); PG8_STAGE(PG8_SB(0, 1), b2 + hstepB, voffB); PG8_STAGE(PG8_SA(0, 0), a2, voffA);
            PG8_WAIT_V(8); PG8_WAIT_L(0); PG8_BAR; PG8_MMA(1, 0, At, B0); PG8_MMA(1, 1, At, B1); PG8_BAR; PG8_SCHED;
            PG8_LDB(B0, 1, 0); PG8_LDB(B1, 1, 1); PG8_SCHED; PG8_LDA(At, 1, 0); PG8_STAGE(PG8_SA(0, 1), a2 + hstepA, voffA);
            PG8_WAIT_V(8); PG8_WAIT_L(0); PG8_BAR; PG8_MMA(0, 0, At, B0); PG8_MMA(0, 1, At, B1); PG8_BAR; PG8_SCHED;
            PG8_LDA(At, 1, 1); PG8_STAGE(PG8_SB(1, 0), b3, voffB); PG8_STAGE(PG8_SB(1, 1), b3 + hstepB, voffB); PG8_STAGE(PG8_SA(1, 0), a3, voffA);
            PG8_WAIT_V(8); PG8_WAIT_L(0); PG8_BAR; PG8_MMA(1, 0, At, B0); PG8_MMA(1, 1, At, B1); PG8_BAR; PG8_SCHED;
        }
        if (wr == 0) PG8_BAR;
        E(acc, cur, wr, wc, fr, fq);
        if (!has_next) break;
#pragma unroll
        for (int a = 0; a < 2; ++a)
#pragma unroll
            for (int b = 0; b < 2; ++b)
#pragma unroll
                for (int m = 0; m < 4; ++m)
#pragma unroll
                    for (int n = 0; n < 2; ++n) acc[a][b][m][n] = (f32x4){0.f, 0.f, 0.f, 0.f};
        cur = nxt; cA = nA; cB = nB; ++ui;
        if (wr == 1) PG8_BAR;
    }
    PG8_WAIT_V(0);
    PG8_BAR;
#undef PG8_SA
#undef PG8_SB
#undef PG8_STAGE
#undef PG8_LDA
#undef PG8_LDB
#undef PG8_MMA
#undef PG8_WAIT_V
#undef PG8_WAIT_L
#undef PG8_BAR
#undef PG8_SCHED
}
}
using pg8::Unit;
typedef const f32x4 (&AccRef)[2][2][4][2];

#define EPI_FENCE() __builtin_amdgcn_sched_barrier(0)
#define EPI_ROW(ai, m) (u.pm * 256 + (ai) * 128 + wr * 64 + (m) * 16 + fr)
struct EpiU {
    static constexpr bool PERM = true, ROWPERM = false;
    const float* rstd; bf16_t* U;
    __device__ __forceinline__ void operator()(AccRef acc, const Unit& u, int wr, int wc, int fr, int fq) const {
        float rs[2][4];
#pragma unroll
        for (int ai = 0; ai < 2; ++ai)
#pragma unroll
            for (int m = 0; m < 4; ++m) rs[ai][m] = rstd[EPI_ROW(ai, m)];
        EPI_FENCE();
#pragma unroll
        for (int ai = 0; ai < 2; ++ai)
#pragma unroll
            for (int m = 0; m < 4; ++m) {
                const int row = EPI_ROW(ai, m);
                bf16_t* base = U + (size_t)(row >> 5) * UP + (row & 31) * 16;
#pragma unroll
                for (int bj = 0; bj < 2; ++bj) { const int ch0 = u.pn * 256 + bj * 128 + wc * 32 + 8 * fq; const int gg = ch0 >> 4, h0 = ch0 & 15;
                    const f32x4 v0 = acc[ai][bj][m][0] * rs[ai][m], v1 = acc[ai][bj][m][1] * rs[ai][m];
                    u32x4 w; w.x = cvt_pk_bf16(v0[0], v0[1]); w.y = cvt_pk_bf16(v0[2], v0[3]); w.z = cvt_pk_bf16(v1[0], v1[1]); w.w = cvt_pk_bf16(v1[2], v1[3]);
                    *(u32x4*)(base + (size_t)gg * (2048 * UP) + h0) = w; } }
    }
};
struct EpiSloc {
    static constexpr bool PERM = false, ROWPERM = false;
    float* S;
    __device__ __forceinline__ void operator()(AccRef acc, const Unit& u, int wr, int wc, int fr, int fq) const {
#pragma unroll
        for (int ai = 0; ai < 2; ++ai)
#pragma unroll
            for (int m = 0; m < 4; ++m) { const int row = EPI_ROW(ai, m);
#pragma unroll
                for (int n = 0; n < 2; ++n) *(f32x4*)(S + (size_t)row * 128 + wc * 32 + 16 * n + 4 * fq) = acc[ai][0][m][n]; }
    }
};
struct EpiSsmOut {
    static constexpr bool PERM = true, ROWPERM = false;
    const bf16_t* U; const float* dskip; bf16_t* G;
    __device__ __forceinline__ void operator()(AccRef acc, const Unit& u, int wr, int wc, int fr, int fq) const {
        const int gg = u.pm >> 3;
#pragma unroll
        for (int bj = 0; bj < 2; ++bj) { const int col0 = u.pn * 256 + bj * 128 + wc * 32 + 8 * fq; const int h0 = col0 & 15;
            const f32x4 d0 = *(const f32x4*)(dskip + gg * 16 + h0), d1 = *(const f32x4*)(dskip + gg * 16 + h0 + 4);
            u32x4 uu[2][4];
#pragma unroll
            for (int ai = 0; ai < 2; ++ai)
#pragma unroll
                for (int m = 0; m < 4; ++m) uu[ai][m] = *(const u32x4*)(U + (size_t)EPI_ROW(ai, m) * UP + col0);
            EPI_FENCE();
#pragma unroll
            for (int ai = 0; ai < 2; ++ai)
#pragma unroll
                for (int m = 0; m < 4; ++m) { const int row = EPI_ROW(ai, m); const u32x4 q = uu[ai][m];
                    f32x4 y0 = acc[ai][bj][m][0], y1 = acc[ai][bj][m][1];
                    y0[0] += d0[0] * bf_lo(q.x); y0[1] += d0[1] * bf_hi(q.x); y0[2] += d0[2] * bf_lo(q.y); y0[3] += d0[3] * bf_hi(q.y);
                    y1[0] += d1[0] * bf_lo(q.z); y1[1] += d1[1] * bf_hi(q.z); y1[2] += d1[2] * bf_lo(q.w); y1[3] += d1[3] * bf_hi(q.w);
                    u32x4 w; w.x = cvt_pk_bf16(gelu_tanh(y0[0]), gelu_tanh(y0[1])); w.y = cvt_pk_bf16(gelu_tanh(y0[2]), gelu_tanh(y0[3]));
                    w.z = cvt_pk_bf16(gelu_tanh(y1[0]), gelu_tanh(y1[1])); w.w = cvt_pk_bf16(gelu_tanh(y1[2]), gelu_tanh(y1[3]));
                    *(u32x4*)(G + (size_t)row * 512 + col0) = w; }
            EPI_FENCE(); }
    }
};
struct EpiGlu {
    static constexpr bool PERM = true, ROWPERM = false;
    const bf16_t* xb; bf16_t* hb; float* ss;
    __device__ __forceinline__ void operator()(AccRef acc, const Unit& u, int wr, int wc, int fr, int fq) const {
        u32x4 xr[2][4];
#pragma unroll
        for (int ai = 0; ai < 2; ++ai)
#pragma unroll
            for (int m = 0; m < 4; ++m) xr[ai][m] = *(const u32x4*)(xb + (size_t)EPI_ROW(ai, m) * D + u.pn * 128 + wc * 32 + 8 * fq);
        EPI_FENCE();
#pragma unroll
        for (int ai = 0; ai < 2; ++ai)
#pragma unroll
            for (int m = 0; m < 4; ++m) { const int row = EPI_ROW(ai, m); const size_t off = (size_t)row * D + u.pn * 128 + wc * 32 + 8 * fq;
                const u32x4 q = xr[ai][m]; const f32x4 v0 = acc[ai][0][m][0], v1 = acc[ai][0][m][1], g0 = acc[ai][1][m][0], g1 = acc[ai][1][m][1];
                f32x4 h0, h1;
                h0[0] = bf_lo(q.x) + v0[0] * sigmoidf_(g0[0]); h0[1] = bf_hi(q.x) + v0[1] * sigmoidf_(g0[1]); h0[2] = bf_lo(q.y) + v0[2] * sigmoidf_(g0[2]); h0[3] = bf_hi(q.y) + v0[3] * sigmoidf_(g0[3]);
                h1[0] = bf_lo(q.z) + v1[0] * sigmoidf_(g1[0]); h1[1] = bf_hi(q.z) + v1[1] * sigmoidf_(g1[1]); h1[2] = bf_lo(q.w) + v1[2] * sigmoidf_(g1[2]); h1[3] = bf_hi(q.w) + v1[3] * sigmoidf_(g1[3]);
                u32x4 w; w.x = cvt_pk_bf16(h0[0], h0[1]); w.y = cvt_pk_bf16(h0[2], h0[3]); w.z = cvt_pk_bf16(h1[0], h1[1]); w.w = cvt_pk_bf16(h1[2], h1[3]);
                *(u32x4*)(hb + off) = w;
                float s2 = (bf_lo(w.x) * bf_lo(w.x) + bf_hi(w.x) * bf_hi(w.x)) + (bf_lo(w.y) * bf_lo(w.y) + bf_hi(w.y) * bf_hi(w.y)) + (bf_lo(w.z) * bf_lo(w.z) + bf_hi(w.z) * bf_hi(w.z)) + (bf_lo(w.w) * bf_lo(w.w) + bf_hi(w.w) * bf_hi(w.w));
                s2 += __shfl_xor(s2, 16); s2 += __shfl_xor(s2, 32);
                if (fq == 0) unsafeAtomicAdd(ss + row, s2); }
    }
};
template <bool LAST> struct EpiResid {
    static constexpr bool PERM = true, ROWPERM = false;
    float* out; bf16_t* hb; float* ss;
    __device__ __forceinline__ void operator()(AccRef acc, const Unit& u, int wr, int wc, int fr, int fq) const {
#pragma unroll
        for (int ai = 0; ai < 2; ++ai) {
            u32x4 rr[4][2];
#pragma unroll
            for (int m = 0; m < 4; ++m)
#pragma unroll
                for (int bj = 0; bj < 2; ++bj) rr[m][bj] = *(const u32x4*)(hb + (size_t)EPI_ROW(ai, m) * D + u.pn * 256 + bj * 128 + wc * 32 + 8 * fq);
            EPI_FENCE();
#pragma unroll
            for (int m = 0; m < 4; ++m) { const int row = EPI_ROW(ai, m); float s = 0.f;
#pragma unroll
                for (int bj = 0; bj < 2; ++bj) { const size_t off = (size_t)row * D + u.pn * 256 + bj * 128 + wc * 32 + 8 * fq;
                    const u32x4 r = rr[m][bj]; f32x4 h0 = acc[ai][bj][m][0], h1 = acc[ai][bj][m][1];
                    h0[0] += bf_lo(r.x); h0[1] += bf_hi(r.x); h0[2] += bf_lo(r.y); h0[3] += bf_hi(r.y); h1[0] += bf_lo(r.z); h1[1] += bf_hi(r.z); h1[2] += bf_lo(r.w); h1[3] += bf_hi(r.w);
                    if (LAST) { *(f32x4*)(out + off) = h0; *(f32x4*)(out + off + 4) = h1; }
                    else { u32x4 w; w.x = cvt_pk_bf16(h0[0], h0[1]); w.y = cvt_pk_bf16(h0[2], h0[3]); w.z = cvt_pk_bf16(h1[0], h1[1]); w.w = cvt_pk_bf16(h1[2], h1[3]);
                        *(u32x4*)(hb + off) = w;
                        s += (bf_lo(w.x) * bf_lo(w.x) + bf_hi(w.x) * bf_hi(w.x)) + (bf_lo(w.y) * bf_lo(w.y) + bf_hi(w.y) * bf_hi(w.y)) + (bf_lo(w.z) * bf_lo(w.z) + bf_hi(w.z) * bf_hi(w.z)) + (bf_lo(w.w) * bf_lo(w.w) + bf_hi(w.w) * bf_hi(w.w)); } }
                if (!LAST) { s += __shfl_xor(s, 16); s += __shfl_xor(s, 32); if (fq == 0) unsafeAtomicAdd(ss + row, s); } }
            EPI_FENCE(); }
    }
};
typedef float f32x2 __attribute__((ext_vector_type(2)));
template <int CTRL> __device__ __forceinline__ float dpp_old(float old, float x) { return __builtin_bit_cast(float, __builtin_amdgcn_update_dpp(__builtin_bit_cast(int, old), __builtin_bit_cast(int, x), CTRL, 0xf, 0xf, false)); }
__device__ __forceinline__ f32x2 silu_mul2(f32x2 gc, f32x2 v) {
    const f32x2 t = gc * (-1.44269504089f); f32x2 e; e.x = __builtin_amdgcn_exp2f(t.x); e.y = __builtin_amdgcn_exp2f(t.y);
    const f32x2 d = e + 1.0f; f32x2 r; r.x = __builtin_amdgcn_rcpf(d.x); r.y = __builtin_amdgcn_rcpf(d.y);
    return (gc * v) * r;
}
struct EpiUp {
    static constexpr bool PERM = true, ROWPERM = true;
    const float* ss; const float* cw; const float* cb; bf16_t* act; bf16_t* bndg;
#define UP_ROW(ai, m) (u.pm * 256 + (ai) * 128 + wr * 64 + 4 * fr + (m))
    __device__ __forceinline__ void operator()(AccRef acc, const Unit& u, int wr, int wc, int fr, int fq) const {
        const int ch0 = u.pn * 128 + wc * 32 + 8 * fq;
        f32x4 w0[2], w1[2], w2[2], bb[2]; float rs[2][4];
#pragma unroll
        for (int n = 0; n < 2; ++n) { w0[n] = *(const f32x4*)(cw + ch0 + 4 * n); w1[n] = *(const f32x4*)(cw + FF + ch0 + 4 * n); w2[n] = *(const f32x4*)(cw + 2 * FF + ch0 + 4 * n); bb[n] = *(const f32x4*)(cb + ch0 + 4 * n); }
#pragma unroll
        for (int ai = 0; ai < 2; ++ai) { const f32x4 q = *(const f32x4*)(ss + UP_ROW(ai, 0)); rs[ai][0] = q[0]; rs[ai][1] = q[1]; rs[ai][2] = q[2]; rs[ai][3] = q[3]; }
        EPI_FENCE();
#pragma unroll
        for (int ai = 0; ai < 2; ++ai) {
            f32x4 gt[4][2], vv[4][2], o[4][2];
#pragma unroll
            for (int m = 0; m < 4; ++m) { const float rsc = __builtin_amdgcn_rsqf(rs[ai][m] * (1.0f / D) + EPS);
#pragma unroll
                for (int n = 0; n < 2; ++n) { gt[m][n] = acc[ai][1][m][n] * rsc; vv[m][n] = acc[ai][0][m][n] * rsc; } }
#pragma unroll
            for (int n = 0; n < 2; ++n)
#pragma unroll
                for (int jp = 0; jp < 4; jp += 2) {
                    const f32x2 g0 = (f32x2){gt[0][n][jp], gt[0][n][jp + 1]}, g1 = (f32x2){gt[1][n][jp], gt[1][n][jp + 1]}, g2 = (f32x2){gt[2][n][jp], gt[2][n][jp + 1]}, g3 = (f32x2){gt[3][n][jp], gt[3][n][jp + 1]};
                    f32x2 s3, s2; s3.x = dpp_old<0x111>(0.f, g3.x); s3.y = dpp_old<0x111>(0.f, g3.y); s2.x = dpp_old<0x111>(0.f, g2.x); s2.y = dpp_old<0x111>(0.f, g2.y);
                    const f32x2 k0 = (f32x2){w0[n][jp], w0[n][jp + 1]}, k1 = (f32x2){w1[n][jp], w1[n][jp + 1]}, k2 = (f32x2){w2[n][jp], w2[n][jp + 1]}, kb = (f32x2){bb[n][jp], bb[n][jp + 1]};
                    const f32x2 c0 = k0 * s2 + (k1 * s3 + (k2 * g0 + kb)), c1 = k0 * s3 + (k1 * g0 + (k2 * g1 + kb)), c2 = k0 * g0 + (k1 * g1 + (k2 * g2 + kb)), c3 = k0 * g1 + (k1 * g2 + (k2 * g3 + kb));
                    const f32x2 o0 = silu_mul2(c0, (f32x2){vv[0][n][jp], vv[0][n][jp + 1]}), o1 = silu_mul2(c1, (f32x2){vv[1][n][jp], vv[1][n][jp + 1]});
                    const f32x2 o2 = silu_mul2(c2, (f32x2){vv[2][n][jp], vv[2][n][jp + 1]}), o3 = silu_mul2(c3, (f32x2){vv[3][n][jp], vv[3][n][jp + 1]});
                    o[0][n][jp] = o0.x; o[0][n][jp + 1] = o0.y; o[1][n][jp] = o1.x; o[1][n][jp + 1] = o1.y; o[2][n][jp] = o2.x; o[2][n][jp + 1] = o2.y; o[3][n][jp] = o3.x; o[3][n][jp + 1] = o3.y; }
#pragma unroll
            for (int m = 0; m < 4; ++m) { const int row = UP_ROW(ai, m); const int r64 = 4 * fr + m; const size_t blk = (size_t)(row >> 6);
                if (r64 >= 2) { u32x4 w; w.x = cvt_pk_bf16(o[m][0][0], o[m][0][1]); w.y = cvt_pk_bf16(o[m][0][2], o[m][0][3]); w.z = cvt_pk_bf16(o[m][1][0], o[m][1][1]); w.w = cvt_pk_bf16(o[m][1][2], o[m][1][3]);
                    *(u32x4*)(act + (size_t)row * FF + ch0) = w; }
                else { u32x4 wg, wv; wg.x = cvt_pk_bf16(gt[m][0][0], gt[m][0][1]); wg.y = cvt_pk_bf16(gt[m][0][2], gt[m][0][3]); wg.z = cvt_pk_bf16(gt[m][1][0], gt[m][1][1]); wg.w = cvt_pk_bf16(gt[m][1][2], gt[m][1][3]);
                       wv.x = cvt_pk_bf16(vv[m][0][0], vv[m][0][1]); wv.y = cvt_pk_bf16(vv[m][0][2], vv[m][0][3]); wv.z = cvt_pk_bf16(vv[m][1][0], vv[m][1][1]); wv.w = cvt_pk_bf16(vv[m][1][2], vv[m][1][3]);
                       *(u32x4*)(bndg + (blk * 4 + 2 + r64) * FF + ch0) = wg; *(u32x4*)(act + (size_t)row * FF + ch0) = wv; }
                if (r64 >= 62) { u32x4 wg; wg.x = cvt_pk_bf16(gt[m][0][0], gt[m][0][1]); wg.y = cvt_pk_bf16(gt[m][0][2], gt[m][0][3]); wg.z = cvt_pk_bf16(gt[m][1][0], gt[m][1][1]); wg.w = cvt_pk_bf16(gt[m][1][2], gt[m][1][3]);
                    *(u32x4*)(bndg + (blk * 4 + (r64 - 62)) * FF + ch0) = wg; } } }
    }
#undef UP_ROW
};
struct EpiQkv {
    static constexpr bool PERM = true, ROWPERM = false;
    const float* ss; const float* qn; const float* kn; bf16_t* Q; bf16_t* Kb;
    __device__ __forceinline__ void operator()(AccRef acc, const Unit& u, int wr, int wc, int fr, int fq) const {
        const int part = u.pn >> 2, head = (u.pn & 3) * 4 + wc;
        const bf16_t* q_ = Q; const bf16_t* k_ = Kb; const float* qn_ = qn; const float* kn_ = kn;
        bf16_t* dst = (bf16_t*)((uintptr_t)q_ + (part > 0 ? (uintptr_t)k_ - (uintptr_t)q_ : 0));
        const float* gn = (const float*)((uintptr_t)qn_ + (part > 0 ? (uintptr_t)kn_ - (uintptr_t)qn_ : 0));
        const float post = part == 0 ? 0.125f * 1.44269504089f : 1.0f;
        f32x4 g[2][2]; float rs[2][4];
#pragma unroll
        for (int bj = 0; bj < 2; ++bj)
#pragma unroll
            for (int n = 0; n < 2; ++n) g[bj][n] = *(const f32x4*)(gn + 32 * bj + 8 * fq + 4 * n) * post;
#pragma unroll
        for (int ai = 0; ai < 2; ++ai)
#pragma unroll
            for (int m = 0; m < 4; ++m) rs[ai][m] = ss[EPI_ROW(ai, m)];
        EPI_FENCE();
#pragma unroll
        for (int ai = 0; ai < 2; ++ai)
#pragma unroll
            for (int m = 0; m < 4; ++m) { const int row = EPI_ROW(ai, m); const float rsc = __builtin_amdgcn_rsqf(rs[ai][m] * (1.0f / D) + EPS);
                f32x4 v[2][2]; float s = 0.f;
#pragma unroll
                for (int bj = 0; bj < 2; ++bj)
#pragma unroll
                    for (int n = 0; n < 2; ++n) { v[bj][n] = acc[ai][bj][m][n] * rsc; s += (v[bj][n][0] * v[bj][n][0] + v[bj][n][1] * v[bj][n][1]) + (v[bj][n][2] * v[bj][n][2] + v[bj][n][3] * v[bj][n][3]); }
                s += __shfl_xor(s, 16); s += __shfl_xor(s, 32);
                const float hr = __builtin_amdgcn_rsqf(s * (1.0f / 64.0f) + EPS);
#pragma unroll
                for (int bj = 0; bj < 2; ++bj) { f32x4 a = v[bj][0], b = v[bj][1];
                    a = a * hr * g[bj][0]; b = b * hr * g[bj][1];
                    u32x4 w; w.x = cvt_pk_bf16(a[0], a[1]); w.y = cvt_pk_bf16(a[2], a[3]); w.z = cvt_pk_bf16(b[0], b[1]); w.w = cvt_pk_bf16(b[2], b[3]);
                    *(u32x4*)(dst + (size_t)row * D + head * 64 + 32 * bj + 8 * fq) = w; } }
    }
};
struct EpiVt {
    static constexpr bool PERM = true, ROWPERM = false;
    const float* ss; bf16_t* Vt;
    __device__ __forceinline__ void operator()(AccRef acc, const Unit& u, int wr, int wc, int fr, int fq) const {
        f32x4 r0[2], r1[2];
#pragma unroll
        for (int bj = 0; bj < 2; ++bj) { const int tok0 = u.pn * 256 + bj * 128 + wc * 32 + 8 * fq; r0[bj] = *(const f32x4*)(ss + tok0); r1[bj] = *(const f32x4*)(ss + tok0 + 4); }
        EPI_FENCE();
#pragma unroll
        for (int bj = 0; bj < 2; ++bj) { const int tok0 = u.pn * 256 + bj * 128 + wc * 32 + 8 * fq;
#pragma unroll
            for (int j = 0; j < 4; ++j) { r0[bj][j] = __builtin_amdgcn_rsqf(r0[bj][j] * (1.0f / D) + EPS); r1[bj][j] = __builtin_amdgcn_rsqf(r1[bj][j] * (1.0f / D) + EPS); }
#pragma unroll
            for (int ai = 0; ai < 2; ++ai)
#pragma unroll
                for (int m = 0; m < 4; ++m) { const int row = EPI_ROW(ai, m); const f32x4 a = acc[ai][bj][m][0] * r0[bj], b = acc[ai][bj][m][1] * r1[bj];
                    u32x4 w; w.x = cvt_pk_bf16(a[0], a[1]); w.y = cvt_pk_bf16(a[2], a[3]); w.z = cvt_pk_bf16(b[0], b[1]); w.w = cvt_pk_bf16(b[2], b[3]);
                    *(u32x4*)(Vt + (size_t)row * M + tok0) = w; } }
    }
};

__device__ __forceinline__ void sincos_red(double ang, float& c, float& s) {
    const double q = __builtin_rint(ang * 0.63661977236758134308);
    double y = __builtin_fma(-q, 1.57079632679489655800, ang); y = __builtin_fma(-q, 6.123233995736766e-17, y);
    const int qi = (int)((long long)q & 3);
    const double y2 = y * y;
    const double sp = y * (1.0 + y2 * (-1.0 / 6 + y2 * (1.0 / 120 + y2 * (-1.0 / 5040 + y2 * (1.0 / 362880 + y2 * (-1.0 / 39916800 + y2 * (1.0 / 6227020800.0)))))));
    const double cp = 1.0 + y2 * (-0.5 + y2 * (1.0 / 24 + y2 * (-1.0 / 720 + y2 * (1.0 / 40320 + y2 * (-1.0 / 3628800 + y2 * (1.0 / 479001600.0))))));
    const float sf = (float)sp, cf = (float)cp;
    c = (qi == 0) ? cf : (qi == 1) ? -sf : (qi == 2) ? -cf : sf;
    s = (qi == 0) ? sf : (qi == 1) ? cf : (qi == 2) ? -sf : -cf;
}
__device__ __forceinline__ void p0_ssm_consts(int g, int qd, const float* lam_re, const float* lam_im, const float* b_re, const float* b_im, const float* c_re, const float* c_im, const float* log_dt,
                                              bf16_t* toep, bf16_t* wst, float* at, LAS float* L, int tid) {
    LAS float* AP = L; LAS float* BB = L + 4224; LAS float* CM = BB + 2048; LAS float* KM = CM + 2048;
    const double dt = exp((double)log_dt[g]);
    for (int it = tid; it < 64 * 33; it += 512) { const int p = it / 33, j = it % 33;
        const double re = (double)lam_re[g * 64 + p] * dt * j, im = (double)lam_im[g * 64 + p] * dt * j;
        float c, s; sincos_red(im, c, s); const float mg = (float)exp(re);
        AP[it * 2] = mg * c; AP[it * 2 + 1] = mg * s; }
    for (int it = tid; it < 1024; it += 512) { const int h = it >> 6, p = it & 63; CM[it * 2] = c_re[(g * 16 + h) * 64 + p]; CM[it * 2 + 1] = c_im[(g * 16 + h) * 64 + p]; }
    __syncthreads();
    for (int it = tid; it < 1024; it += 512) { const int p = it >> 4, h = it & 15;
        const float lr = lam_re[g * 64 + p], li = lam_im[g * 64 + p], xr = AP[(p * 33 + 1) * 2] - 1.0f, xi = AP[(p * 33 + 1) * 2 + 1];
        const float den = 1.0f / (lr * lr + li * li), zr = (xr * lr + xi * li) * den, zi = (xi * lr - xr * li) * den;
        const float br = b_re[(g * 64 + p) * 16 + h], bi = b_im[(g * 64 + p) * 16 + h];
        BB[it * 2] = zr * br - zi * bi; BB[it * 2 + 1] = zr * bi + zi * br; }
    if (qd == 0 && tid < 64) { at[(g * 64 + tid) * 2] = AP[(tid * 33 + 32) * 2]; at[(g * 64 + tid) * 2 + 1] = AP[(tid * 33 + 32) * 2 + 1]; }
    __syncthreads();
    for (int o = tid; o < 2048; o += 512) { const int j = o >> 6, hl = (o >> 4) & 3, hp = o & 15, h = 4 * qd + hl; float acc = 0.f;
        for (int p = 0; p < 64; ++p) { const float cr = CM[(h * 64 + p) * 2], ci = CM[(h * 64 + p) * 2 + 1], ar = AP[(p * 33 + j) * 2], ai = AP[(p * 33 + j) * 2 + 1];
            const float er = cr * ar - ci * ai, ei = cr * ai + ci * ar; acc += er * BB[(p * 16 + hp) * 2] - ei * BB[(p * 16 + hp) * 2 + 1]; }
        KM[o] = acc; }
    __syncthreads();
    bf16_t* tg = toep + (size_t)g * 512 * UP;
    for (int ci = tid; ci < 128 * 80; ci += 512) { const int rl = ci / 80, col0 = (ci % 80) * 8, t = rl >> 2, hl = rl & 3, h = 4 * qd + hl, row = t * 16 + h; float v[8];
        if (col0 < 512) { const int s = col0 >> 4, h0 = col0 & 15;
#pragma unroll
            for (int e = 0; e < 8; ++e) v[e] = (s <= t) ? KM[((t - s) * 4 + hl) * 16 + h0 + e] : 0.f; }
        else { const int q0 = col0 - 512; const bool imp = q0 >= 64; const int p0 = imp ? q0 - 64 : q0;
#pragma unroll
            for (int e = 0; e < 8; ++e) { const int p = p0 + e; const float cr = CM[(h * 64 + p) * 2], cim = CM[(h * 64 + p) * 2 + 1], ar = AP[(p * 33 + t + 1) * 2], aim = AP[(p * 33 + t + 1) * 2 + 1];
                v[e] = imp ? -(cr * aim + cim * ar) : (cr * ar - cim * aim); } }
        u32x4 w; w.x = pk2(v[0], v[1]); w.y = pk2(v[2], v[3]); w.z = pk2(v[4], v[5]); w.w = pk2(v[6], v[7]);
        *(u32x4*)(tg + (size_t)row * UP + col0) = w; }
    bf16_t* wg = wst + (size_t)g * 256 * 512;
    for (int ci = tid; ci < 64 * 64; ci += 512) { const int q = 64 * qd + (ci >> 6), col0 = (ci & 63) * 8, s = col0 >> 4, h0 = col0 & 15; float v[8];
        if (q < 128) { const bool imp = q >= 64; const int p = imp ? q - 64 : q; const float ar = AP[(p * 33 + 31 - s) * 2], aim = AP[(p * 33 + 31 - s) * 2 + 1];
#pragma unroll
            for (int e = 0; e < 8; ++e) { const float br = BB[(p * 16 + h0 + e) * 2], bi = BB[(p * 16 + h0 + e) * 2 + 1]; v[e] = imp ? (ar * bi + aim * br) : (ar * br - aim * bi); } }
        else {
#pragma unroll
            for (int e = 0; e < 8; ++e) v[e] = 0.f; }
        u32x4 w; w.x = pk2(v[0], v[1]); w.y = pk2(v[2], v[3]); w.z = pk2(v[4], v[5]); w.w = pk2(v[6], v[7]);
        *(u32x4*)(wg + (size_t)q * 512 + col0) = w; }
    __syncthreads();
}
__device__ __forceinline__ void p0_transpose_item(const float* W, int K, int Nsrc, const float* gain, bf16_t* WT, int k0, int srccol0, int dstrow0, LAS float* scr, int lane) {
    float v[32];
#pragma unroll
    for (int i = 0; i < 32; ++i) { const int kk = 2 * i + (lane >> 5); v[i] = W[(size_t)(k0 + kk) * Nsrc + srccol0 + (lane & 31)]; }
    if (gain) {
#pragma unroll
        for (int i = 0; i < 32; ++i) v[i] *= gain[k0 + 2 * i + (lane >> 5)]; }
#pragma unroll
    for (int i = 0; i < 32; ++i) scr[(2 * i + (lane >> 5)) * 33 + (lane & 31)] = v[i];
    asm volatile("s_waitcnt lgkmcnt(0)" ::: "memory");
    const int c = lane & 7;
#pragma unroll
    for (int j = 0; j < 4; ++j) { const int n = (lane >> 3) + 8 * j; const LAS float* s = scr + (8 * c) * 33 + n;
        u32x4 o; o.x = pk2(s[0 * 33], s[1 * 33]); o.y = pk2(s[2 * 33], s[3 * 33]); o.z = pk2(s[4 * 33], s[5 * 33]); o.w = pk2(s[6 * 33], s[7 * 33]);
        *(u32x4*)(WT + (size_t)(dstrow0 + n) * K + k0 + 8 * c) = o; }
    asm volatile("s_waitcnt lgkmcnt(0)" ::: "memory");
}
__device__ __forceinline__ int map_col(int kind, int n, int Fh) {
    if (kind == 1) { const int pn = n >> 8, half = (n >> 7) & 1, j = n & 127; return half * Fh + 128 * pn + j; }
    if (kind == 2) { const int pn = n >> 8, pos = n & 255, bj = pos >> 7, wc = (pos >> 5) & 3, i = pos & 31; return 256 * pn + 64 * wc + 32 * bj + i; }
    return n;
}

constexpr int KP = 72, VP = 68;
constexpr int SLOT_BYTES = 64 * KP * 2 + 64 * VP * 2, NSLOT = 7;
__device__ __forceinline__ void attn_phase(LAS unsigned char* lds, const bf16_t* Q, const bf16_t* Kb, const bf16_t* Vt, bf16_t* O, int G, int c) {
    LAS int* flags = (LAS int*)(lds + NSLOT * SLOT_BYTES);
    int tid_ = threadIdx.x; asm volatile("" : "+v"(tid_));
    const int tid = tid_, w = __builtin_amdgcn_readfirstlane(tid >> 6), lane = tid & 63, hf = lane >> 5, n = lane & 31;
    const int lrow = tid >> 3, lch = tid & 7;
#define ATT_KS(t) ((LAS bf16_t*)(lds + ((t) % NSLOT) * SLOT_BYTES))
#define ATT_VS(t) ((LAS bf16_t*)(lds + ((t) % NSLOT) * SLOT_BYTES + 64 * KP * 2))
#define ATT_WRITE(t, kr, vr) do { *(LAS u32x4*)(ATT_KS(t) + lrow * KP + 8 * lch) = kr; LAS u32x2* vp_ = (LAS u32x2*)(ATT_VS(t) + lrow * VP + 8 * lch); u32x2 lo_, hi_; lo_.x = vr.x; lo_.y = vr.y; hi_.x = vr.z; hi_.y = vr.w; vp_[0] = lo_; vp_[1] = hi_; } while (0)
    const int cx = (G % 8 == 0) ? (c & 7) * (G >> 3) + (c >> 3) : c;
    u32x4 pkr[5], pvr[5]; bf16x8 pqf[4];
#define ATT_PREFETCH(uix) do { const int qb_ = (uix) & 7, bh_ = (uix) >> 3, b_ = bh_ >> 4, h_ = bh_ & 15, kb_ = (qb_ * 256) >> 6; const size_t t0_ = (size_t)b_ * SEQ; \
        const bf16_t* kg_ = Kb + (t0_ + lrow) * D + h_ * 64 + 8 * lch; const bf16_t* vg_ = Vt + (size_t)(h_ * 64 + lrow) * M + t0_ + 8 * lch; \
        _Pragma("unroll") for (int i_ = 0; i_ < 5; ++i_) { const int t_ = kb_ - 1 + i_; if (t_ >= 0) { pkr[i_] = *(const u32x4*)(kg_ + (size_t)t_ * 64 * D); pvr[i_] = *(const u32x4*)(vg_ + t_ * 64); } } \
        _Pragma("unroll") for (int ds_ = 0; ds_ < 4; ++ds_) pqf[ds_] = *(const bf16x8*)(Q + (t0_ + qb_ * 256 + 32 * w + n) * D + h_ * 64 + 16 * ds_ + 8 * hf); } while (0)
#pragma unroll
    for (int i = 0; i < 5; ++i) { pkr[i] = (u32x4){0, 0, 0, 0}; pvr[i] = (u32x4){0, 0, 0, 0}; }
    if (cx < BATCH * 16 * 8) ATT_PREFETCH(cx);
    for (int ui = cx; ui < BATCH * 16 * 8; ui += G) {
        const int qb = ui & 7, bh = ui >> 3, b = bh >> 4, h = bh & 15, q0 = qb * 256;
        const size_t tok0 = (size_t)b * SEQ;
        const int qpos = q0 + 32 * w + n, kbase = q0 >> 6, kd = kbase + (w >> 1);
        bf16x8 qf[4];
#pragma unroll
        for (int ds = 0; ds < 4; ++ds) qf[ds] = pqf[ds];
        f32x16 o0, o1;
#pragma unroll
        for (int i = 0; i < 16; ++i) { o0[i] = 0.f; o1[i] = 0.f; }
        float carry = 1.0f; bool wdone = false;
        if (tid < 8) flags[tid] = 0;
        const bf16_t* kg = Kb + (tok0 + lrow) * D + h * 64 + 8 * lch;
        const bf16_t* vg = Vt + (size_t)(h * 64 + lrow) * M + tok0 + 8 * lch;
#pragma unroll
        for (int i = 0; i < 5; ++i) { const int t_ = kbase - 1 + i; if (t_ >= 0) ATT_WRITE(t_, pkr[i], pvr[i]); }
        if (ui + G < BATCH * 16 * 8) ATT_PREFETCH(ui + G);
        __syncthreads();
        for (int s = 0;; ++s) {
            if (s >= 2) {
                const int tn = kbase - s;
                if (tn >= 0) { const u32x4 kr_ = *(const u32x4*)(kg + (size_t)tn * 64 * D), vr_ = *(const u32x4*)(vg + tn * 64); ATT_WRITE(tn, kr_, vr_); }
                __syncthreads(); }
            const int t = kd - s;
            if (t < 0) wdone = true;
            if (!wdone) {
                const LAS bf16_t* Ks = ATT_KS(t); const LAS bf16_t* Vs = ATT_VS(t);
                f32x16 s0, s1;
#pragma unroll
                for (int i = 0; i < 16; ++i) { s0[i] = 0.f; s1[i] = 0.f; }
                const bool diag = (s == 0);
                const bool hi_ok = !(diag && ((w & 1) == 0));
#pragma unroll
                for (int ds = 0; ds < 4; ++ds) {
                    const bf16x8 ka0 = *(const LAS bf16x8*)(Ks + n * KP + 16 * ds + 8 * hf);
                    s0 = __builtin_amdgcn_mfma_f32_32x32x16_bf16(ka0, qf[ds], s0, 0, 0, 0); }
                if (hi_ok) {
#pragma unroll
                    for (int ds = 0; ds < 4; ++ds) { const bf16x8 ka1 = *(const LAS bf16x8*)(Ks + (32 + n) * KP + 16 * ds + 8 * hf);
                        s1 = __builtin_amdgcn_mfma_f32_32x32x16_bf16(ka1, qf[ds], s1, 0, 0, 0); } }
                f32x2 E[2][2][4], I[2][2][4], W[2][2][4]; float tot[8], ptot[8], exg[8];
#define ATT_S(kb, r) ((kb) ? s1[r] : s0[r])
#define ATT_EXP(kb) _Pragma("unroll") for (int pi = 0; pi < 2; ++pi) _Pragma("unroll") for (int j = 0; j < 4; ++j) { \
                        E[kb][pi][j].x = __builtin_amdgcn_exp2f(__builtin_amdgcn_fmed3f(ATT_S(kb, 8 * pi + j), -126.0f, 30.0f)); E[kb][pi][j].y = __builtin_amdgcn_exp2f(__builtin_amdgcn_fmed3f(ATT_S(kb, 8 * pi + 4 + j), -126.0f, 30.0f)); }
#define ATT_MASK(kb) _Pragma("unroll") for (int pi = 0; pi < 2; ++pi) _Pragma("unroll") for (int j = 0; j < 4; ++j) { const int key_ = 64 * t + 32 * kb + 16 * pi + 4 * hf + j; \
                        E[kb][pi][j].x = (key_ >= qpos) ? 0.0f : E[kb][pi][j].x; E[kb][pi][j].y = (key_ + 8 >= qpos) ? 0.0f : E[kb][pi][j].y; }
#define ATT_GROUPS(kb) _Pragma("unroll") for (int pi = 0; pi < 2; ++pi) { const f32x2 d0 = E[kb][pi][0] + 1.0f, d1 = E[kb][pi][1] + 1.0f, d2 = E[kb][pi][2] + 1.0f, d3 = E[kb][pi][3] + 1.0f; \
                        const f32x2 b01 = d0 * d1, c012 = b01 * d2, dd = c012 * d3; f32x2 R; R.x = __builtin_amdgcn_rcpf(dd.x); R.y = __builtin_amdgcn_rcpf(dd.y); \
                        I[kb][pi][0] = R; I[kb][pi][1] = R * d0; I[kb][pi][2] = R * b01; I[kb][pi][3] = R * c012; tot[4 * kb + 2 * pi] = R.x; tot[4 * kb + 2 * pi + 1] = R.y; }
#define ATT_WEIGHTS(kb) _Pragma("unroll") for (int pi = 0; pi < 2; ++pi) { const f32x2 ex2 = (f32x2){exg[4 * kb + 2 * pi], exg[4 * kb + 2 * pi + 1]}; \
                        _Pragma("unroll") for (int j = 0; j < 4; ++j) W[kb][pi][j] = E[kb][pi][j] * (ex2 * I[kb][pi][j]); }
                ATT_EXP(0)
                if (hi_ok) { ATT_EXP(1) }
                if (diag) { if (w & 1) { ATT_MASK(1) } else { ATT_MASK(0) } }
                ATT_GROUPS(0)
                if (hi_ok) { ATT_GROUPS(1) }
                else {
#pragma unroll
                    for (int i = 0; i < 4; ++i) tot[4 + i] = 1.0f; }
#pragma unroll
                for (int i = 0; i < 4; ++i) ptot[i] = __shfl_xor(tot[i], 32);
                if (hi_ok) {
#pragma unroll
                    for (int i = 4; i < 8; ++i) ptot[i] = __shfl_xor(tot[i], 32); }
                else {
#pragma unroll
                    for (int i = 4; i < 8; ++i) ptot[i] = 1.0f; }
                float run = carry;
#pragma unroll
                for (int idx = 7; idx >= 0; --idx) { if (idx >= 4 && !hi_ok) continue;
                    const float a = hf ? 1.0f : ptot[idx]; exg[idx] = run * a; run = (run * tot[idx]) * ptot[idx]; }
                ATT_WEIGHTS(0)
                if (hi_ok) { ATT_WEIGHTS(1) }
#undef ATT_S
#undef ATT_EXP
#undef ATT_MASK
#undef ATT_GROUPS
#undef ATT_WEIGHTS
                carry = run;
#pragma unroll
                for (int kb = 0; kb < 2; ++kb) { if (kb == 1 && !hi_ok) continue;
#pragma unroll
                    for (int s2 = 0; s2 < 2; ++s2) {
                        union { u32x4 u; bf16x8 v; } pf;
                        pf.u.x = cvt_pk_bf16(W[kb][s2][0].x, W[kb][s2][1].x); pf.u.y = cvt_pk_bf16(W[kb][s2][2].x, W[kb][s2][3].x);
                        pf.u.z = cvt_pk_bf16(W[kb][s2][0].y, W[kb][s2][1].y); pf.u.w = cvt_pk_bf16(W[kb][s2][2].y, W[kb][s2][3].y);
#pragma unroll
                        for (int db = 0; db < 2; ++db) {
                            const LAS bf16_t* vp = Vs + (32 * db + n) * VP + 32 * kb + 16 * s2 + 4 * hf;
                            union { u32x4 u; bf16x8 v; } vf; const u32x2 lo = *(const LAS u32x2*)vp, hi = *(const LAS u32x2*)(vp + 8);
                            vf.u.x = lo.x; vf.u.y = lo.y; vf.u.z = hi.x; vf.u.w = hi.y;
                            if (db == 0) o0 = __builtin_amdgcn_mfma_f32_32x32x16_bf16(vf.v, pf.v, o0, 0, 0, 0); else o1 = __builtin_amdgcn_mfma_f32_32x32x16_bf16(vf.v, pf.v, o1, 0, 0, 0); } } }
                wdone = (__ballot(carry >= 1e-15f) == 0ull);
            }
            if (s >= 1) {
                if (lane == 0) flags[w] = wdone ? 1 : 0;
                __syncthreads();
                int all = 1;
#pragma unroll
                for (int i = 0; i < 8; ++i) all &= flags[i];
                if (all) break; }
        }
        { LAS bf16_t* Os = (LAS bf16_t*)(lds + w * (32 * 72 * 2));
#pragma unroll
          for (int i = 0; i < 4; ++i) { u32x2 a, bq; a.x = cvt_pk_bf16(o0[4 * i], o0[4 * i + 1]); a.y = cvt_pk_bf16(o0[4 * i + 2], o0[4 * i + 3]); bq.x = cvt_pk_bf16(o1[4 * i], o1[4 * i + 1]); bq.y = cvt_pk_bf16(o1[4 * i + 2], o1[4 * i + 3]);
              *(LAS u32x2*)(Os + n * 72 + 8 * i + 4 * hf) = a; *(LAS u32x2*)(Os + n * 72 + 32 + 8 * i + 4 * hf) = bq; }
          asm volatile("s_waitcnt lgkmcnt(0)" ::: "memory");
          const int orow = lane >> 3, och = lane & 7;
#pragma unroll
          for (int k = 0; k < 4; ++k) { const u32x4 v = *(const LAS u32x4*)(Os + (8 * k + orow) * 72 + 8 * och);
              *(u32x4*)(O + (tok0 + q0 + 32 * w + 8 * k + orow) * D + h * 64 + 8 * och) = v; } }
        __syncthreads();
    }
#undef ATT_KS
#undef ATT_VS
#undef ATT_WRITE
#undef ATT_PREFETCH
}

#define XB_TMO      128
#define XB_XCNT(j)  (256  + 64 * (j))
#define XB_XSUB(j)  (1280 + 64 * (j))
#define XB_XGEN(j)  (2304 + 64 * (j))
#define XB_TOP      3328
#define XB_TOPGEN   3392
#define XCD_BAR_WORDS 3456
#define XB_SPIN_CAP (1u << 20)
__device__ __forceinline__ unsigned xb_ld(unsigned* p)              { return __hip_atomic_load(p, __ATOMIC_RELAXED, __HIP_MEMORY_SCOPE_AGENT); }
__device__ __forceinline__ unsigned xb_add(unsigned* p, unsigned v) { return __hip_atomic_fetch_add(p, v, __ATOMIC_RELAXED, __HIP_MEMORY_SCOPE_AGENT); }
__device__ __forceinline__ unsigned xb_xcc_id() { return (unsigned)__builtin_amdgcn_s_getreg((3 << 11) | 20) & 0xFu; }
#define XB_SPIN(cond, bar) do { unsigned _sp = 0; while (cond) { __builtin_amdgcn_s_sleep(1); \
    if ((++_sp & 255u) == 0u) { if (xb_ld(&(bar)[XB_TMO])) break; if (_sp > XB_SPIN_CAP) { atomicAdd(&(bar)[XB_TMO], 1u); break; } } } } while (0)
struct XcdBarrier { unsigned* bar; unsigned x; volatile LAS unsigned* st; };
__device__ __forceinline__ unsigned xcd_barrier_post(unsigned* bar, unsigned x) { return xb_add(&bar[XB_XCNT(x)], 1u); }
__device__ __forceinline__ void xcd_barrier_complete(unsigned* bar, unsigned x, unsigned& nloc, unsigned& nx) {
    const unsigned G = gridDim.x * gridDim.y * gridDim.z;
    unsigned sum, cnt, mine, sp = 0u;
    for (;;) {
        sum = 0u; cnt = 0u; mine = 0u;
#pragma unroll
        for (unsigned j = 0; j < 16; ++j) { const unsigned c = xb_ld(&bar[XB_XCNT(j)]); sum += c; cnt += (c > 0u) ? 1u : 0u; mine = (j == x) ? c : mine; }
        if (sum == G) break;
        __builtin_amdgcn_s_sleep(1);
        if ((++sp & 255u) == 0u) { if (xb_ld(&bar[XB_TMO])) break; if (sp > XB_SPIN_CAP) { atomicAdd(&bar[XB_TMO], 1u); break; } }
    }
    nloc = mine > 0u ? mine : 1u; nx = cnt > 0u ? cnt : 1u;
}
__device__ __forceinline__ void xcd_barrier(const XcdBarrier& b) {
    asm volatile("s_waitcnt vmcnt(0)" ::: "memory");
    __syncthreads();
    if (threadIdx.x == 0) {
        unsigned* bar = b.bar;
        __builtin_amdgcn_s_waitcnt(0);
        unsigned nloc = b.st[0], nx = b.st[1];
        if (nloc == 0u) { xcd_barrier_complete(bar, b.x, nloc, nx); b.st[0] = nloc; b.st[1] = nx; }
        const unsigned old = xb_add(&bar[XB_XSUB(b.x)], 1u);
        const unsigned gen = old / nloc;
        if (old + 1u == (gen + 1u) * nloc) {
            __builtin_amdgcn_fence(__ATOMIC_RELEASE, "agent");
            asm volatile("s_waitcnt vmcnt(0)" ::: "memory");
            const unsigned og = xb_add(&bar[XB_TOP], 1u);
            const unsigned tg = og / nx;
            if (og + 1u == (tg + 1u) * nx) xb_add(&bar[XB_TOPGEN], 1u);
            else XB_SPIN(xb_ld(&bar[XB_TOPGEN]) == tg, bar);
            __builtin_amdgcn_fence(__ATOMIC_ACQUIRE, "agent");
            xb_add(&bar[XB_XGEN(b.x)], 1u);
            asm volatile("s_waitcnt vmcnt(0)" ::: "memory");
        } else {
            XB_SPIN(xb_ld(&bar[XB_XGEN(b.x)]) == gen, bar);
            __builtin_amdgcn_fence(__ATOMIC_ACQUIRE, "agent");
            asm volatile("s_waitcnt vmcnt(0)" ::: "memory");
        }
    }
    __syncthreads();
}
constexpr int LDS_VCU = 131072 + 128;
constexpr int LDS_BARST = 131072 + 64;
constexpr size_t WS_BAR = 16384;

struct Args { const float* in[24]; float* out; unsigned char* ws; };
#define CAS __attribute__((address_space(4)))
__device__ __forceinline__ const CAS Args* fresh_args() { const CAS Args* p = (const CAS Args*)__builtin_amdgcn_kernarg_segment_ptr(); asm volatile("" : "+s"(p)); return p; }
#define WSP(T, off) ((T*)(ws + (off)))
#define GRID_BAR() do { const CAS Args* A_ = fresh_args(); XcdBarrier b_; b_.bar = (unsigned*)(A_->ws + WS_BAR); b_.x = xb_xcc_id(); b_.st = (volatile LAS unsigned*)(lds + LDS_BARST); xcd_barrier(b_); } while (0)
__global__ void __launch_bounds__(512, 2) yoco_fwd(Args a_unused) {
    extern __shared__ __attribute__((aligned(16))) unsigned char lds_raw[];
    LAS unsigned char* lds = (LAS unsigned char*)lds_raw;
    cg::grid_group grid = cg::this_grid();
    if (threadIdx.x < 2) ((LAS unsigned*)(lds + LDS_BARST))[threadIdx.x] = 0u;
    if (blockIdx.x == 0) { const CAS Args* A_ = fresh_args(); unsigned* bar_ = (unsigned*)(A_->ws + WS_BAR); for (int i = threadIdx.x; i < XCD_BAR_WORDS; i += 512) bar_[i] = 0u; }
    __syncthreads();

    {
        const CAS Args* A = fresh_args(); unsigned char* ws = A->ws;
        int tid_ = threadIdx.x; asm volatile("" : "+v"(tid_));
        const int tid = tid_, lane = tid & 63, wave = __builtin_amdgcn_readfirstlane(tid >> 6), G = gridDim.x, bx = blockIdx.x;
        for (int gq = bx; gq < NG * 4; gq += G) p0_ssm_consts(gq >> 2, gq & 3, A->in[3], A->in[4], A->in[5], A->in[6], A->in[7], A->in[8], A->in[10], WSP(bf16_t, WS_TOEP), WSP(bf16_t, WS_WST), WSP(float, WS_AT), (LAS float*)lds, tid);
        const int gw = bx * 8 + wave, NGW = G * 8;
        LAS float* scr = (LAS float*)(lds + wave * 16384);
        for (int it = gw; it < 12032; it += NGW) {
            int r = it; const float* W; const float* gain = nullptr; bf16_t* dst; int K = 1024, Nsrc, Ndst, kind = 0, Fh = 0, base = 0;
            if (r < 512) { W = A->in[2]; gain = A->in[1]; dst = WSP(bf16_t, WS_WIN); Nsrc = 1024; Ndst = 1024; }
            else if ((r -= 512) < 1024) { W = A->in[11]; dst = WSP(bf16_t, WS_WGLU); Nsrc = 2048; Ndst = 2048; kind = 1; Fh = 1024; }
            else if ((r -= 1024) < 512) { W = A->in[16]; gain = A->in[15]; dst = WSP(bf16_t, WS_WQKV); Nsrc = 1024; Ndst = 1024; kind = 2; }
            else if ((r -= 512) < 512) { W = A->in[13]; gain = A->in[12]; dst = WSP(bf16_t, WS_WQKV) + (size_t)1024 * 1024; Nsrc = 2048; Ndst = 1024; kind = 2; }
            else if ((r -= 512) < 512) { W = A->in[13]; gain = A->in[12]; dst = WSP(bf16_t, WS_WQKV) + (size_t)2048 * 1024; Nsrc = 2048; Ndst = 1024; kind = 0; base = 1024; }
            else if ((r -= 512) < 512) { W = A->in[18]; dst = WSP(bf16_t, WS_WO); Nsrc = 1024; Ndst = 1024; }
            else if ((r -= 512) < 2816) { W = A->in[20]; gain = A->in[19]; dst = WSP(bf16_t, WS_UP0); Nsrc = 2 * FF; Ndst = 2 * FF; kind = 1; Fh = FF; }
            else if ((r -= 2816) < 2816) { W = A->in[20] + (size_t)D * 2 * FF; gain = A->in[19] + D; dst = WSP(bf16_t, WS_UP1); Nsrc = 2 * FF; Ndst = 2 * FF; kind = 1; Fh = FF; }
            else if ((r -= 2816) < 1408) { W = A->in[23]; dst = WSP(bf16_t, WS_DN0); K = FF; Nsrc = 1024; Ndst = 1024; }
            else { r -= 1408; W = A->in[23] + (size_t)FF * D; dst = WSP(bf16_t, WS_DN1); K = FF; Nsrc = 1024; Ndst = 1024; }
            const int nblk = Ndst / 32, kb = r / nblk, nb = r % nblk;
            p0_transpose_item(W, K, Nsrc, gain, dst, 64 * kb, base + map_col(kind, 32 * nb, Fh), 32 * nb, scr, lane);
        }
        const float* x = A->in[0]; float* rstd0 = WSP(float, WS_RSTD0); bf16_t* XB = WSP(bf16_t, WS_XB);
        for (int m = gw; m < M; m += 4 * NGW) {
            f32x4 v[4][4]; float sq[4];
#pragma unroll
            for (int r = 0; r < 4; ++r) { const f32x4* xr = (const f32x4*)(x + (size_t)(m + r * NGW) * D) + lane;
#pragma unroll
                for (int j = 0; j < 4; ++j) v[r][j] = xr[64 * j]; }
#pragma unroll
            for (int r = 0; r < 4; ++r) { float q = 0.f;
#pragma unroll
                for (int j = 0; j < 4; ++j) q += (v[r][j][0] * v[r][j][0] + v[r][j][1] * v[r][j][1]) + (v[r][j][2] * v[r][j][2] + v[r][j][3] * v[r][j][3]);
                sq[r] = wave_sum(q); }
#pragma unroll
            for (int r = 0; r < 4; ++r) { if (lane == 0) rstd0[m + r * NGW] = 1.0f / sqrtf(sq[r] * (1.0f / D) + EPS);
                u32x2* o8 = (u32x2*)(XB + (size_t)(m + r * NGW) * D) + lane;
#pragma unroll
                for (int j = 0; j < 4; ++j) { u32x2 w; w.x = pk2(v[r][j][0], v[r][j][1]); w.y = pk2(v[r][j][2], v[r][j][3]); o8[64 * j] = w; } }
        }
        float* ss1 = WSP(float, WS_SS1);
        for (int i = bx * 512 + tid; i < 3 * M; i += G * 512) ss1[i] = 0.f;
    }
    grid.sync();
    if (threadIdx.x == 0) {
        const CAS Args* A_ = fresh_args(); unsigned* bar_ = (unsigned*)(A_->ws + WS_BAR); const unsigned x_ = xb_xcc_id(); const unsigned rk_ = xcd_barrier_post(bar_, x_);
        unsigned nloc_, nx_; xcd_barrier_complete(bar_, x_, nloc_, nx_);
        ((volatile LAS unsigned*)(lds + LDS_BARST))[0] = nloc_; ((volatile LAS unsigned*)(lds + LDS_BARST))[1] = nx_;
        bool ok_ = (gridDim.x % 8u) == 0u;
        for (unsigned j = 0; j < 16; ++j) { const unsigned cnt_ = xb_ld(&bar_[XB_XCNT(j)]); ok_ = ok_ && (cnt_ == (j < 8u ? gridDim.x / 8u : 0u)); }
        ((LAS unsigned*)(lds + LDS_VCU))[0] = ok_ ? rk_ * 8u + x_ : blockIdx.x; }
    __syncthreads();
#define VCU() ((int)__builtin_amdgcn_readfirstlane(((volatile LAS unsigned*)(lds + LDS_VCU))[0]))


    { const CAS Args* A = fresh_args(); unsigned char* ws = A->ws; pg8::StaticOrder S;
      pg8::Gemm g{WSP(bf16_t, WS_XB), WSP(bf16_t, WS_WIN), M, D, D, 2 * D, 32, 0}; S.init(M, D, gridDim.x, VCU()); EpiU E{WSP(float, WS_RSTD0), WSP(bf16_t, WS_UBUF)}; pg8::gemm_phase(lds, g, S, E); }
    GRID_BAR();
    { const CAS Args* A = fresh_args(); unsigned char* ws = A->ws; pg8::StaticOrder S;
      pg8::Gemm g{WSP(bf16_t, WS_UBUF), WSP(bf16_t, WS_WST), NG * 2048, 256, 512, 2 * UP, 32, (size_t)256 * 512 * 2}; S.init(NG * 2048, 256, gridDim.x, VCU()); EpiSloc E{WSP(float, WS_SLOC)}; pg8::gemm_phase(lds, g, S, E); }
    GRID_BAR();
    { const CAS Args* A = fresh_args(); unsigned char* ws = A->ws; const float* AT = WSP(float, WS_AT); const float* SLOC = WSP(float, WS_SLOC); bf16_t* UBUF = WSP(bf16_t, WS_UBUF);
      int tid_ = threadIdx.x; asm volatile("" : "+v"(tid_));
      for (int gid = blockIdx.x * 512 + tid_; gid < NG * BATCH * 64; gid += gridDim.x * 512) {
        const int p = gid & 63, b = (gid >> 6) & 31, g = gid >> 11; const float ar = AT[(g * 64 + p) * 2], ai = AT[(g * 64 + p) * 2 + 1];
        float hr = 0.f, hi = 0.f; const size_t r0 = (size_t)g * 2048 + b * 64;
        for (int c0 = 0; c0 < NCH; c0 += 8) { float sr[8], si[8];
#pragma unroll
            for (int k = 0; k < 8; ++k) { sr[k] = SLOC[(r0 + c0 + k) * 128 + p]; si[k] = SLOC[(r0 + c0 + k) * 128 + 64 + p]; }
#pragma unroll
            for (int k = 0; k < 8; ++k) { bf16_t* up = UBUF + (r0 + c0 + k) * UP + 512 + p; up[0] = (bf16_t)f2bf(hr); up[64] = (bf16_t)f2bf(hi);
                const float nr = ar * hr - ai * hi + sr[k], ni = ar * hi + ai * hr + si[k]; hr = nr; hi = ni; } }
      } }
    GRID_BAR();
    { const CAS Args* A = fresh_args(); unsigned char* ws = A->ws; pg8::StaticOrder S;
      pg8::Gemm g{WSP(bf16_t, WS_UBUF), WSP(bf16_t, WS_TOEP), NG * 2048, 512, UP, 2 * UP, 32, (size_t)512 * UP * 2}; S.init(NG * 2048, 512, gridDim.x, VCU());
      EpiSsmOut E{WSP(bf16_t, WS_UBUF), A->in[9], WSP(bf16_t, WS_GBUF)}; pg8::gemm_phase(lds, g, S, E); }
    GRID_BAR();
    { const CAS Args* A = fresh_args(); unsigned char* ws = A->ws; pg8::StaticOrder S;
      pg8::Gemm g{WSP(bf16_t, WS_GBUF), WSP(bf16_t, WS_WGLU), M, 2 * D, D, 32, (unsigned)((size_t)M * 16 * 2), 0}; S.init(M, 2 * D, gridDim.x, VCU());
      EpiGlu E{WSP(bf16_t, WS_XB), WSP(bf16_t, WS_HB), WSP(float, WS_SS1)}; pg8::gemm_phase(lds, g, S, E); }
    GRID_BAR();
#pragma unroll 1
    for (int layer = 0; layer < 2; ++layer) {
        if (layer == 1) {
            { const CAS Args* A = fresh_args(); unsigned char* ws = A->ws; pg8::StaticOrder S;
              pg8::Gemm g{WSP(bf16_t, WS_HB), WSP(bf16_t, WS_WQKV), M, 2 * D, D, 2 * D, 32, 0}; S.init(M, 2 * D, gridDim.x, VCU());
              EpiQkv E{WSP(float, WS_SS2), A->in[17], A->in[14], WSP(bf16_t, WS_Q), WSP(bf16_t, WS_K)}; pg8::gemm_phase(lds, g, S, E); }
            { const CAS Args* A = fresh_args(); unsigned char* ws = A->ws; pg8::StaticOrder S;
              pg8::Gemm g{WSP(bf16_t, WS_WQKV) + (size_t)2048 * 1024, WSP(bf16_t, WS_HB), D, M, D, 2 * D, 32, 0}; S.init(D, M, gridDim.x, VCU());
              EpiVt E{WSP(float, WS_SS2), WSP(bf16_t, WS_V)}; pg8::gemm_phase(lds, g, S, E); }
            GRID_BAR();
            { const CAS Args* A = fresh_args(); unsigned char* ws = A->ws; attn_phase(lds, WSP(bf16_t, WS_Q), WSP(bf16_t, WS_K), WSP(bf16_t, WS_V), WSP(bf16_t, WS_O), gridDim.x, VCU()); }
            GRID_BAR();
            { const CAS Args* A = fresh_args(); unsigned char* ws = A->ws; pg8::StaticOrder S;
              pg8::Gemm g{WSP(bf16_t, WS_O), WSP(bf16_t, WS_WO), M, D, D, 2 * D, 32, 0}; S.init(M, D, gridDim.x, VCU()); EpiResid<false> E{nullptr, WSP(bf16_t, WS_HB), WSP(float, WS_SS3)}; pg8::gemm_phase(lds, g, S, E); }
            GRID_BAR();
        }
        { const CAS Args* A = fresh_args(); unsigned char* ws = A->ws; pg8::StaticOrder S;
          pg8::Gemm g{WSP(bf16_t, WS_HB), WSP(bf16_t, WS_UP0 + (size_t)layer * (WS_UP1 - WS_UP0)), M, 2 * FF, D, 2 * D, 32, 0}; S.init(M, 2 * FF, gridDim.x, VCU());
          EpiUp E{WSP(float, WS_SS1 + (size_t)layer * (WS_SS3 - WS_SS1)), A->in[21] + (size_t)layer * 3 * FF, A->in[22] + (size_t)layer * FF, WSP(bf16_t, WS_ACT), WSP(bf16_t, WS_BNDG)}; pg8::gemm_phase(lds, g, S, E); }
        GRID_BAR();
        { const CAS Args* A = fresh_args(); unsigned char* ws = A->ws; const float* cw = A->in[21] + (size_t)layer * 3 * FF; const float* cb = A->in[22] + (size_t)layer * FF;
          const bf16_t* BNDG = WSP(bf16_t, WS_BNDG); bf16_t* ACT = WSP(bf16_t, WS_ACT);
          int tid_ = threadIdx.x; asm volatile("" : "+v"(tid_));
          for (int i = blockIdx.x * 512 + tid_; i < 1024 * 2 * (FF / 8); i += gridDim.x * 512) { const int c8 = i % (FF / 8), r = (i / (FF / 8)) & 1, k = i / (2 * (FF / 8)); const int ch = 8 * c8;
            const u32x4 zero = (u32x4){0, 0, 0, 0}; const bool first = (k & 31) == 0;
            const u32x4 qm2 = first ? zero : *(const u32x4*)(BNDG + ((size_t)(k - 1) * 4 + 0) * FF + ch), qm1 = first ? zero : *(const u32x4*)(BNDG + ((size_t)(k - 1) * 4 + 1) * FF + ch);
            const u32x4 q0 = *(const u32x4*)(BNDG + ((size_t)k * 4 + 2) * FF + ch), q1 = *(const u32x4*)(BNDG + ((size_t)k * 4 + 3) * FF + ch);
            bf16_t* ap = ACT + ((size_t)k * 64 + r) * FF + ch; const u32x4 qv = *(const u32x4*)ap;
            const u32x4 ta = r == 0 ? qm2 : qm1, tb = r == 0 ? qm1 : q0, tc = r == 0 ? q0 : q1;
            float res[8];
#pragma unroll
            for (int e = 0; e < 8; ++e) { const unsigned wa = e < 2 ? ta.x : e < 4 ? ta.y : e < 6 ? ta.z : ta.w, wb = e < 2 ? tb.x : e < 4 ? tb.y : e < 6 ? tb.z : tb.w, wc_ = e < 2 ? tc.x : e < 4 ? tc.y : e < 6 ? tc.z : tc.w, wv = e < 2 ? qv.x : e < 4 ? qv.y : e < 6 ? qv.z : qv.w;
                const float fa = (e & 1) ? bf_hi(wa) : bf_lo(wa), fb = (e & 1) ? bf_hi(wb) : bf_lo(wb), fc = (e & 1) ? bf_hi(wc_) : bf_lo(wc_), fv = (e & 1) ? bf_hi(wv) : bf_lo(wv);
                const float gc = cb[ch + e] + cw[ch + e] * fa + cw[FF + ch + e] * fb + cw[2 * FF + ch + e] * fc;
                res[e] = gc * sigmoidf_(gc) * fv; }
            u32x4 w; w.x = pk2(res[0], res[1]); w.y = pk2(res[2], res[3]); w.z = pk2(res[4], res[5]); w.w = pk2(res[6], res[7]);
            *(u32x4*)ap = w; } }
        GRID_BAR();
        if (layer == 0) { { const CAS Args* A = fresh_args(); unsigned char* ws = A->ws; pg8::StaticOrder S;
            pg8::Gemm g{WSP(bf16_t, WS_ACT), WSP(bf16_t, WS_DN0), M, D, FF, 2 * FF, 32, 0}; S.init(M, D, gridDim.x, VCU()); EpiResid<false> E{nullptr, WSP(bf16_t, WS_HB), WSP(float, WS_SS2)}; pg8::gemm_phase(lds, g, S, E); }
            GRID_BAR(); }
        else { const CAS Args* A = fresh_args(); unsigned char* ws = A->ws; pg8::StaticOrder S;
            pg8::Gemm g{WSP(bf16_t, WS_ACT), WSP(bf16_t, WS_DN1), M, D, FF, 2 * FF, 32, 0}; S.init(M, D, gridDim.x, VCU()); EpiResid<true> E{A->out, WSP(bf16_t, WS_HB), nullptr}; pg8::gemm_phase(lds, g, S, E); }
    }
}

extern "C" void kernel_launch(void* const* d_in, const int* in_sizes, int n_in, void* d_out, int out_size, void* d_ws, size_t ws_size, hipStream_t stream) {
    static int grid = 0;
    if (grid == 0) {
        if (n_in != 24 || in_sizes[0] != M * D || out_size != M * D || ws_size < WS_END) { fprintf(stderr, "kernel_launch: unexpected shapes (n_in %d, in0 %d, out %d, ws %zu)\n", n_in, n_in > 0 ? in_sizes[0] : -1, out_size, ws_size); grid = -1; return; }
        int dev = 0, cus = 0, per_cu = 0;
        hipGetDevice(&dev); hipDeviceGetAttribute(&cus, hipDeviceAttributeMultiprocessorCount, dev);
        if (hipFuncSetAttribute((const void*)yoco_fwd, hipFuncAttributeMaxDynamicSharedMemorySize, LDS_BYTES) != hipSuccess) { fprintf(stderr, "kernel_launch: hipFuncSetAttribute failed\n"); grid = -1; return; }
        if (hipOccupancyMaxActiveBlocksPerMultiprocessor(&per_cu, (const void*)yoco_fwd, 512, LDS_BYTES) != hipSuccess || per_cu < 1) { fprintf(stderr, "kernel_launch: occupancy query says %d\n", per_cu); per_cu = 1; }
        (void)hipGetLastError();
        grid = cus;
    }
    if (grid < 0) return;
    Args a{};
    for (int i = 0; i < 24; ++i) a.in[i] = (const float*)d_in[i];
    a.out = (float*)d_out; a.ws = (unsigned char*)d_ws;
    void* args[] = {&a};
    hipError_t e = hipLaunchCooperativeKernel((const void*)yoco_fwd, dim3(grid), dim3(512), args, LDS_BYTES, stream);
    if (e != hipSuccess) fprintf(stderr, "cooperative launch failed: %s (grid %d)\n", hipGetErrorString(e), grid);
}
```

```cpp
#include <hip/hip_runtime.h>
#include <hip/hip_cooperative_groups.h>
#include <cstdio>
#include <cstdint>
namespace cg = cooperative_groups;

#define LAS __attribute__((address_space(3)))
typedef unsigned short bf16_t;
typedef short bf16x8 __attribute__((ext_vector_type(8)));
typedef float f32x4 __attribute__((ext_vector_type(4)));
typedef float f32x16 __attribute__((ext_vector_type(16)));
typedef unsigned u32x4 __attribute__((ext_vector_type(4)));
typedef unsigned u32x2 __attribute__((ext_vector_type(2)));

constexpr int D = 1024, SEQ = 2048, BATCH = 32, M = BATCH * SEQ, FF = 2816, NG = 64, TS = 32  , NCH = SEQ / TS;
constexpr int UP = 640;
constexpr float EPS = 1e-6f;
constexpr size_t MiB = 1u << 20;
constexpr size_t WS_RSTD0 = 1 * MiB, WS_SS1 = WS_RSTD0 + 262144, WS_SS2 = WS_SS1 + 262144, WS_SS3 = WS_SS2 + 262144;
constexpr size_t WS_WIN = 2 * MiB, WS_WGLU = 4 * MiB, WS_WQKV = 8 * MiB, WS_WO = 14 * MiB, WS_UP0 = 16 * MiB, WS_UP1 = 27 * MiB, WS_DN0 = 38 * MiB, WS_DN1 = 44 * MiB;
constexpr size_t WS_TOEP = 50 * MiB, WS_WST = 90 * MiB, WS_AT = 106 * MiB;
constexpr size_t WS_XB = 128 * MiB, WS_GBUF = 480 * MiB  , WS_Q = 128 * MiB;
constexpr size_t WS_UBUF = 256 * MiB, WS_HB = 256 * MiB;
constexpr size_t WS_SLOC = 416 * MiB;
constexpr size_t WS_ACT = 480 * MiB, WS_K = 480 * MiB, WS_V = 608 * MiB, WS_O = 736 * MiB;
constexpr size_t WS_BNDG = 864 * MiB, WS_BNDV = 908 * MiB, WS_END = 930 * MiB;
constexpr int LDS_BYTES = 135168;

__device__ __forceinline__ unsigned f2bf(float f) { unsigned u = __builtin_bit_cast(unsigned, f); return (u + 0x7fffu + ((u >> 16) & 1u)) >> 16; }
__device__ __forceinline__ unsigned pk2(float lo, float hi) { return f2bf(lo) | (f2bf(hi) << 16); }
__device__ __forceinline__ unsigned cvt_pk_bf16(float lo, float hi) { unsigned r; asm volatile("v_cvt_pk_bf16_f32 %0, %1, %2" : "=v"(r) : "v"(lo), "v"(hi)); return r; }
__device__ __forceinline__ float bf_lo(unsigned w) { return __builtin_bit_cast(float, w << 16); }
__device__ __forceinline__ float bf_hi(unsigned w) { return __builtin_bit_cast(float, w & 0xffff0000u); }
__device__ __forceinline__ float sigmoidf_(float y) { return __builtin_amdgcn_rcpf(1.0f + __builtin_amdgcn_exp2f(-1.44269504089f * y)); }
__device__ __forceinline__ float gelu_tanh(float x) { return x * sigmoidf_(1.5957691216f * (x + 0.044715f * x * x * x)); }
template <int CTRL> __device__ __forceinline__ float dppf(float x) { return __builtin_bit_cast(float, __builtin_amdgcn_update_dpp(0, __builtin_bit_cast(int, x), CTRL, 0xf, 0xf, false)); }
__device__ __forceinline__ float wave_sum(float v) {
#pragma unroll
    for (int o = 1; o < 64; o <<= 1) v += __shfl_xor(v, o);
    return v;
}

namespace pg8 {
constexpr int BM = 256, BK = 64, HALF = 128, HTB = HALF * BK * 2, STAGE_BYTES = 8 * HTB, NXCD = 8, WGM = 8;
__host__ __device__ __forceinline__ int lds_byte(int r, int c) { const int st = (r >> 4) * 2 + (c >> 5), rr = r & 15, cc = c & 31, ob = rr * 64 + cc * 2; return st * 1024 + (ob ^ (((ob >> 9) & 1) << 5)); }
__host__ __device__ __forceinline__ void stage_rc(int b, int& R, int& C) { const int st = b / 1024, sb = b % 1024, swz = sb ^ (((sb >> 9) & 1) << 5); R = (st >> 1) * 16 + swz / 64; C = (st & 1) * 32 + (swz % 64) / 2; }
__host__ __device__ __forceinline__ int perm32(int rho) { const int n = rho >> 4, i = rho & 15; return 8 * (i >> 2) + 4 * n + (i & 3); }

struct Unit { int pm, pn; };
struct Gemm { const bf16_t* A; const bf16_t* Bt; int M, N, K; unsigned a_row, a_cg; size_t b_gstride; };

struct StaticOrder {
    int nM, nN, nwg, G, c;
    __device__ void init(int M_, int N_, int G_, int c_) { nM = M_ / BM; nN = N_ / BM; nwg = nM * nN; G = G_; c = c_; }
    __device__ bool next(int i, Unit& u) const {
        const long L = (long)i * G + c; if (L >= nwg) return false;
        int wgid = (int)L; { const int q = nwg / NXCD, r = nwg % NXCD, xcd = wgid % NXCD, off = wgid / NXCD; wgid = (xcd < r ? xcd * (q + 1) : r * (q + 1) + (xcd - r) * q) + off; }
        const int nig = WGM * nN, gid = wgid / nig, fm = gid * WGM, gsz = (nM - fm) < WGM ? (nM - fm) : WGM;
        u.pm = fm + ((wgid % nig) % gsz); u.pn = (wgid % nig) / gsz; return true;
    }
};

template <class Epi>
__device__ __forceinline__ void gemm_phase(LAS unsigned char* lds, const Gemm g, const StaticOrder S, const Epi E) {
    int tid_ = threadIdx.x; asm volatile("" : "+v"(tid_));
    const int tid = tid_, wid = __builtin_amdgcn_readfirstlane(tid >> 6), lane = tid & 63, wr = wid >> 2, wc = wid & 3, fr = lane & 15, fq = lane >> 4;
    const int K = g.K, nt = K / BK;
    unsigned voffA[2], voffB[2];
#pragma unroll
    for (int i = 0; i < 2; ++i) { int R, C; stage_rc(tid * 16 + i * 8192, R, C); const int Rb = Epi::PERM ? ((R & ~31) + perm32(R & 31)) : R;
        const int Ra = Epi::ROWPERM ? ((R & ~63) | ((R & 15) << 2) | ((R >> 4) & 3)) : R;
        voffA[i] = (unsigned)(C >> 4) * g.a_cg + (unsigned)Ra * g.a_row + (unsigned)(C & 15) * 2u; voffB[i] = (unsigned)(Rb * K + C) * 2u; }
    const size_t kstepA = (size_t)g.a_cg * 4, kstepB = (size_t)(BK * 2);
    const size_t hstepA = (size_t)HALF * g.a_row, hstepB = (size_t)HALF * K * 2;
    const size_t tstepA = 2 * hstepA, tstepB = 2 * hstepB;
    const unsigned ldsw = (unsigned)wid * 1024u;
    const int aoff = lds_byte(wr * 64 + fr, fq * 8), boff = lds_byte(wc * 32 + fr, fq * 8);
#define PG8_SA(b, h) (((b) * 2 + (h)) * HTB)
#define PG8_SB(b, h) ((4 + (b) * 2 + (h)) * HTB)
#define PG8_STAGE(bufoff, gbase, voff) do { _Pragma("unroll") for (int _i = 0; _i < 2; ++_i) \
        __builtin_amdgcn_global_load_lds((const unsigned*)((const char*)(gbase) + (voff)[_i]), (LAS unsigned*)(lds + (bufoff) + ldsw + _i * 8192), 16, 0, 0); } while (0)
#define PG8_LDA(dst, b, h) do { _Pragma("unroll") for (int m = 0; m < 4; ++m) _Pragma("unroll") for (int k = 0; k < 2; ++k) dst[m][k] = *(const LAS bf16x8*)(lds + PG8_SA(b, h) + aoff + m * 2048 + k * 1024); } while (0)
#define PG8_LDB(dst, b, h) do { _Pragma("unroll") for (int n = 0; n < 2; ++n) _Pragma("unroll") for (int k = 0; k < 2; ++k) dst[n][k] = *(const LAS bf16x8*)(lds + PG8_SB(b, h) + boff + n * 2048 + k * 1024); } while (0)
#define PG8_MMA(ai, bj, At, Bt) do { __builtin_amdgcn_s_setprio(1); _Pragma("unroll") for (int m = 0; m < 4; ++m) _Pragma("unroll") for (int n = 0; n < 2; ++n) _Pragma("unroll") for (int k = 0; k < 2; ++k) \
        acc[ai][bj][m][n] = __builtin_amdgcn_mfma_f32_16x16x32_bf16(Bt[n][k], At[m][k], acc[ai][bj][m][n], 0, 0, 0); __builtin_amdgcn_s_setprio(0); } while (0)
#define PG8_WAIT_V(n) asm volatile("s_waitcnt vmcnt(" #n ")" ::: "memory")
#define PG8_WAIT_L(n) asm volatile("s_waitcnt lgkmcnt(" #n ")" ::: "memory")
#define PG8_BAR __builtin_amdgcn_s_barrier()
#define PG8_SCHED __builtin_amdgcn_sched_barrier(0)
    Unit cur, nxt; int ui = 0;
    if (!S.next(0, cur)) return;
    f32x4 acc[2][2][4][2];
#pragma unroll
    for (int a = 0; a < 2; ++a)
#pragma unroll
        for (int b = 0; b < 2; ++b)
#pragma unroll
            for (int m = 0; m < 4; ++m)
#pragma unroll
                for (int n = 0; n < 2; ++n) acc[a][b][m][n] = (f32x4){0.f, 0.f, 0.f, 0.f};
    bf16x8 At[4][2], B0[2][2], B1[2][2];
    const char* cA = (const char*)g.A + (size_t)cur.pm * tstepA; const char* cB = (const char*)g.Bt + (size_t)(cur.pm >> 3) * g.b_gstride + (size_t)cur.pn * tstepB;
    PG8_STAGE(PG8_SB(0, 0), cB, voffB); PG8_STAGE(PG8_SB(0, 1), cB + hstepB, voffB); PG8_STAGE(PG8_SA(0, 0), cA, voffA); PG8_STAGE(PG8_SA(0, 1), cA + hstepA, voffA);
    if (wr == 1) PG8_BAR;
    PG8_WAIT_V(2); PG8_BAR;
    PG8_STAGE(PG8_SB(1, 0), cB + kstepB, voffB); PG8_STAGE(PG8_SA(1, 0), cA + kstepA, voffA); PG8_STAGE(PG8_SB(1, 1), cB + hstepB + kstepB, voffB);
    PG8_WAIT_V(6); PG8_BAR;
    for (;;) {
        const bool has_next = S.next(ui + 1, nxt);
        const char* nA = has_next ? (const char*)g.A + (size_t)nxt.pm * tstepA : cA;
        const char* nB = has_next ? (const char*)g.Bt + (size_t)(nxt.pm >> 3) * g.b_gstride + (size_t)nxt.pn * tstepB : cB;
        for (int t = 0; t < nt; t += 2) {
            const bool last = (t == nt - 2);
            const char* a1 = cA + (size_t)(t + 1) * kstepA;
            const char* a2 = last ? nA : cA + (size_t)(t + 2) * kstepA; const char* b2 = last ? nB : cB + (size_t)(t + 2) * kstepB;
            const char* a3 = a2 + kstepA; const char* b3 = b2 + kstepB;
            PG8_LDB(B0, 0, 0); PG8_LDB(B1, 0, 1); PG8_SCHED; PG8_LDA(At, 0, 0); PG8_STAGE(PG8_SA(1, 1), a1 + hstepA, voffA);
            PG8_WAIT_V(8); PG8_WAIT_L(0); PG8_BAR; PG8_MMA(0, 0, At, B0); PG8_MMA(0, 1, At, B1); PG8_BAR; PG8_SCHED;
            PG8_LDA(At, 0, 1); PG8_STAGE(PG8_SB(0, 0), b2, voffB); PG8_STAGE(PG8_SB(0, 1), b2 + hstepB, voffB); PG8_STAGE(PG8_SA(0, 0), a2, voffA);
            PG8_WAIT_V(8); PG8_WAIT_L(0); PG8_BAR; PG8_MMA(1, 0, At, B0); PG8_MMA(1, 1, At, B1); PG8_BAR; PG8_SCHED;
            PG8_LDB(B0, 1, 0); PG8_LDB(B1, 1, 1); PG8_SCHED; PG8_LDA(At, 1, 0); PG8_STAGE(PG8_SA(0, 1), a2 + hstepA, voffA);
            PG8_WAIT_V(8); PG8_WAIT_L(0); PG8_BAR; PG8_MMA(0, 0, At, B0); PG8_MMA(0, 1, At, B1); PG8_BAR; PG8_SCHED;
            PG8_LDA(At, 1, 1); PG8_STAGE(PG8_SB(1, 0), b3, voffB); PG8_STAGE(PG8_SB(1, 1), b3 + hstepB, voffB); PG8_STAGE(PG8_SA(1, 0), a3, voffA);
            PG8_WAIT_V(8); PG8_WAIT_L(0); PG8_BAR; PG8_MMA(1, 0, At, B0); PG8_MMA(1, 1, At, B1); PG8_BAR; PG8_SCHED;
        }
        if (wr == 0) PG8_BAR;
        E(acc, cur, wr, wc, fr, fq);
        if (!has_next) break;
#pragma unroll
        for (int a = 0; a < 2; ++a)
#pragma unroll
            for (int b = 0; b < 2; ++b)
#pragma unroll
                for (int m = 0; m < 4; ++m)
#pragma unroll
                    for (int n = 0; n < 2; ++n) acc[a][b][m][n] = (f32x4){0.f, 0.f, 0.f, 0.f};
        cur = nxt; cA = nA; cB = nB; ++ui;
        if (wr == 1) PG8_BAR;
    }
    PG8_WAIT_V(0);
    PG8_BAR;
#undef PG8_SA
#undef PG8_SB
#undef PG8_STAGE
#undef PG8_LDA
#undef PG8_LDB
#undef PG8_MMA
#undef PG8_WAIT_V
#undef PG8_WAIT_L
#undef PG8_BAR
#undef PG8_SCHED
}
}
using pg8::Unit;
typedef const f32x4 (&AccRef)[2][2][4][2];

#define EPI_FENCE() __builtin_amdgcn_sched_barrier(0)
#define EPI_ROW(ai, m) (u.pm * 256 + (ai) * 128 + wr * 64 + (m) * 16 + fr)
struct EpiU {
    static constexpr bool PERM = true, ROWPERM = false;
    const float* rstd; bf16_t* U;
    __device__ __forceinline__ void operator()(AccRef acc, const Unit& u, int wr, int wc, int fr, int fq) const {
        float rs[2][4];
#pragma unroll
        for (int ai = 0; ai < 2; ++ai)
#pragma unroll
            for (int m = 0; m < 4; ++m) rs[ai][m] = rstd[EPI_ROW(ai, m)];
        EPI_FENCE();
#pragma unroll
        for (int ai = 0; ai < 2; ++ai)
#pragma unroll
            for (int m = 0; m < 4; ++m) {
                const int row = EPI_ROW(ai, m);
                bf16_t* base = U + (size_t)(row >> 5) * UP + (row & 31) * 16;
#pragma unroll
                for (int bj = 0; bj < 2; ++bj) { const int ch0 = u.pn * 256 + bj * 128 + wc * 32 + 8 * fq; const int gg = ch0 >> 4, h0 = ch0 & 15;
                    const f32x4 v0 = acc[ai][bj][m][0] * rs[ai][m], v1 = acc[ai][bj][m][1] * rs[ai][m];
                    u32x4 w; w.x = cvt_pk_bf16(v0[0], v0[1]); w.y = cvt_pk_bf16(v0[2], v0[3]); w.z = cvt_pk_bf16(v1[0], v1[1]); w.w = cvt_pk_bf16(v1[2], v1[3]);
                    *(u32x4*)(base + (size_t)gg * (2048 * UP) + h0) = w; } }
    }
};
struct EpiSloc {
    static constexpr bool PERM = false, ROWPERM = false;
    float* S;
    __device__ __forceinline__ void operator()(AccRef acc, const Unit& u, int wr, int wc, int fr, int fq) const {
#pragma unroll
        for (int ai = 0; ai < 2; ++ai)
#pragma unroll
            for (int m = 0; m < 4; ++m) { const int row = EPI_ROW(ai, m);
#pragma unroll
                for (int n = 0; n < 2; ++n) *(f32x4*)(S + (size_t)row * 128 + wc * 32 + 16 * n + 4 * fq) = acc[ai][0][m][n]; }
    }
};
struct EpiSsmOut {
    static constexpr bool PERM = true, ROWPERM = false;
    const bf16_t* U; const float* dskip; bf16_t* G;
    __device__ __forceinline__ void operator()(AccRef acc, const Unit& u, int wr, int wc, int fr, int fq) const {
        const int gg = u.pm >> 3;
#pragma unroll
        for (int bj = 0; bj < 2; ++bj) { const int col0 = u.pn * 256 + bj * 128 + wc * 32 + 8 * fq; const int h0 = col0 & 15;
            const f32x4 d0 = *(const f32x4*)(dskip + gg * 16 + h0), d1 = *(const f32x4*)(dskip + gg * 16 + h0 + 4);
            u32x4 uu[2][4];
#pragma unroll
            for (int ai = 0; ai < 2; ++ai)
#pragma unroll
                for (int m = 0; m < 4; ++m) uu[ai][m] = *(const u32x4*)(U + (size_t)EPI_ROW(ai, m) * UP + col0);
            EPI_FENCE();
#pragma unroll
            for (int ai = 0; ai < 2; ++ai)
#pragma unroll
                for (int m = 0; m < 4; ++m) { const int row = EPI_ROW(ai, m); const u32x4 q = uu[ai][m];
                    f32x4 y0 = acc[ai][bj][m][0], y1 = acc[ai][bj][m][1];
                    y0[0] += d0[0] * bf_lo(q.x); y0[1] += d0[1] * bf_hi(q.x); y0[2] += d0[2] * bf_lo(q.y); y0[3] += d0[3] * bf_hi(q.y);
                    y1[0] += d1[0] * bf_lo(q.z); y1[1] += d1[1] * bf_hi(q.z); y1[2] += d1[2] * bf_lo(q.w); y1[3] += d1[3] * bf_hi(q.w);
                    u32x4 w; w.x = cvt_pk_bf16(gelu_tanh(y0[0]), gelu_tanh(y0[1])); w.y = cvt_pk_bf16(gelu_tanh(y0[2]), gelu_tanh(y0[3]));
                    w.z = cvt_pk_bf16(gelu_tanh(y1[0]), gelu_tanh(y1[1])); w.w = cvt_pk_bf16(gelu_tanh(y1[2]), gelu_tanh(y1[3]));
                    *(u32x4*)(G + (size_t)row * 512 + col0) = w; }
            EPI_FENCE(); }
    }
};
struct EpiGlu {
    static constexpr bool PERM = true, ROWPERM = false;
    const bf16_t* xb; bf16_t* hb; float* ss;
    __device__ __forceinline__ void operator()(AccRef acc, const Unit& u, int wr, int wc, int fr, int fq) const {
        u32x4 xr[2][4];
#pragma unroll
        for (int ai = 0; ai < 2; ++ai)
#pragma unroll
            for (int m = 0; m < 4; ++m) xr[ai][m] = *(const u32x4*)(xb + (size_t)EPI_ROW(ai, m) * D + u.pn * 128 + wc * 32 + 8 * fq);
        EPI_FENCE();
#pragma unroll
        for (int ai = 0; ai < 2; ++ai)
#pragma unroll
            for (int m = 0; m < 4; ++m) { const int row = EPI_ROW(ai, m); const size_t off = (size_t)row * D + u.pn * 128 + wc * 32 + 8 * fq;
                const u32x4 q = xr[ai][m]; const f32x4 v0 = acc[ai][0][m][0], v1 = acc[ai][0][m][1], g0 = acc[ai][1][m][0], g1 = acc[ai][1][m][1];
                f32x4 h0, h1;
                h0[0] = bf_lo(q.x) + v0[0] * sigmoidf_(g0[0]); h0[1] = bf_hi(q.x) + v0[1] * sigmoidf_(g0[1]); h0[2] = bf_lo(q.y) + v0[2] * sigmoidf_(g0[2]); h0[3] = bf_hi(q.y) + v0[3] * sigmoidf_(g0[3]);
                h1[0] = bf_lo(q.z) + v1[0] * sigmoidf_(g1[0]); h1[1] = bf_hi(q.z) + v1[1] * sigmoidf_(g1[1]); h1[2] = bf_lo(q.w) + v1[2] * sigmoidf_(g1[2]); h1[3] = bf_hi(q.w) + v1[3] * sigmoidf_(g1[3]);
                u32x4 w; w.x = cvt_pk_bf16(h0[0], h0[1]); w.y = cvt_pk_bf16(h0[2], h0[3]); w.z = cvt_pk_bf16(h1[0], h1[1]); w.w = cvt_pk_bf16(h1[2], h1[3]);
                *(u32x4*)(hb + off) = w;
                float s2 = (bf_lo(w.x) * bf_lo(w.x) + bf_hi(w.x) * bf_hi(w.x)) + (bf_lo(w.y) * bf_lo(w.y) + bf_hi(w.y) * bf_hi(w.y)) + (bf_lo(w.z) * bf_lo(w.z) + bf_hi(w.z) * bf_hi(w.z)) + (bf_lo(w.w) * bf_lo(w.w) + bf_hi(w.w) * bf_hi(w.w));
                s2 += __shfl_xor(s2, 16); s2 += __shfl_xor(s2, 32);
                if (fq == 0) unsafeAtomicAdd(ss + row, s2); }
    }
};
template <bool LAST> struct EpiResid {
    static constexpr bool PERM = true, ROWPERM = false;
    float* out; bf16_t* hb; float* ss;
    __device__ __forceinline__ void operator()(AccRef acc, const Unit& u, int wr, int wc, int fr, int fq) const {
#pragma unroll
        for (int ai = 0; ai < 2; ++ai) {
            u32x4 rr[4][2];
#pragma unroll
            for (int m = 0; m < 4; ++m)
#pragma unroll
                for (int bj = 0; bj < 2; ++bj) rr[m][bj] = *(const u32x4*)(hb + (size_t)EPI_ROW(ai, m) * D + u.pn * 256 + bj * 128 + wc * 32 + 8 * fq);
            EPI_FENCE();
#pragma unroll
            for (int m = 0; m < 4; ++m) { const int row = EPI_ROW(ai, m); float s = 0.f;
#pragma unroll
                for (int bj = 0; bj < 2; ++bj) { const size_t off = (size_t)row * D + u.pn * 256 + bj * 128 + wc * 32 + 8 * fq;
                    const u32x4 r = rr[m][bj]; f32x4 h0 = acc[ai][bj][m][0], h1 = acc[ai][bj][m][1];
                    h0[0] += bf_lo(r.x); h0[1] += bf_hi(r.x); h0[2] += bf_lo(r.y); h0[3] += bf_hi(r.y); h1[0] += bf_lo(r.z); h1[1] += bf_hi(r.z); h1[2] += bf_lo(r.w); h1[3] += bf_hi(r.w);
                    if (LAST) { *(f32x4*)(out + off) = h0; *(f32x4*)(out + off + 4) = h1; }
                    else { u32x4 w; w.x = cvt_pk_bf16(h0[0], h0[1]); w.y = cvt_pk_bf16(h0[2], h0[3]); w.z = cvt_pk_bf16(h1[0], h1[1]); w.w = cvt_pk_bf16(h1[2], h1[3]);
                        *(u32x4*)(hb + off) = w;
                        s += (bf_lo(w.x) * bf_lo(w.x) + bf_hi(w.x) * bf_hi(w.x)) + (bf_lo(w.y) * bf_lo(w.y) + bf_hi(w.y) * bf_hi(w.y)) + (bf_lo(w.z) * bf_lo(w.z) + bf_hi(w.z) * bf_hi(w.z)) + (bf_lo(w.w) * bf_lo(w.w) + bf_hi(w.w) * bf_hi(w.w)); } }
                if (!LAST) { s += __shfl_xor(s, 16); s += __shfl_xor(s, 32); if (fq == 0) unsafeAtomicAdd(ss + row, s); } }
            EPI_FENCE(); }
    }
};
typedef float f32x2 __attribute__((ext_vector_type(2)));
template <int CTRL> __device__ __forceinline__ float dpp_old(float old, float x) { return __builtin_bit_cast(float, __builtin_amdgcn_update_dpp(__builtin_bit_cast(int, old), __builtin_bit_cast(int, x), CTRL, 0xf, 0xf, false)); }
__device__ __forceinline__ f32x2 silu_mul2(f32x2 gc, f32x2 v) {
    const f32x2 t = gc * (-1.44269504089f); f32x2 e; e.x = __builtin_amdgcn_exp2f(t.x); e.y = __builtin_amdgcn_exp2f(t.y);
    const f32x2 d = e + 1.0f; f32x2 r; r.x = __builtin_amdgcn_rcpf(d.x); r.y = __builtin_amdgcn_rcpf(d.y);
    return (gc * v) * r;
}
struct EpiUp {
    static constexpr bool PERM = true, ROWPERM = true;
    const float* ss; const float* cw; const float* cb; bf16_t* act; bf16_t* bndg;
#define UP_ROW(ai, m) (u.pm * 256 + (ai) * 128 + wr * 64 + 4 * fr + (m))
    __device__ __forceinline__ void operator()(AccRef acc, const Unit& u, int wr, int wc, int fr, int fq) const {
        const int ch0 = u.pn * 128 + wc * 32 + 8 * fq;
        f32x4 w0[2], w1[2], w2[2], bb[2]; float rs[2][4];
#pragma unroll
        for (int n = 0; n < 2; ++n) { w0[n] = *(const f32x4*)(cw + ch0 + 4 * n); w1[n] = *(const f32x4*)(cw + FF + ch0 + 4 * n); w2[n] = *(const f32x4*)(cw + 2 * FF + ch0 + 4 * n); bb[n] = *(const f32x4*)(cb + ch0 + 4 * n); }
#pragma unroll
        for (int ai = 0; ai < 2; ++ai) { const f32x4 q = *(const f32x4*)(ss + UP_ROW(ai, 0)); rs[ai][0] = q[0]; rs[ai][1] = q[1]; rs[ai][2] = q[2]; rs[ai][3] = q[3]; }
        EPI_FENCE();
#pragma unroll
        for (int ai = 0; ai < 2; ++ai) {
            f32x4 gt[4][2], vv[4][2], o[4][2];
#pragma unroll
            for (int m = 0; m < 4; ++m) { const float rsc = __builtin_amdgcn_rsqf(rs[ai][m] * (1.0f / D) + EPS);
#pragma unroll
                for (int n = 0; n < 2; ++n) { gt[m][n] = acc[ai][1][m][n] * rsc; vv[m][n] = acc[ai][0][m][n] * rsc; } }
#pragma unroll
            for (int n = 0; n < 2; ++n)
#pragma unroll
                for (int jp = 0; jp < 4; jp += 2) {
                    const f32x2 g0 = (f32x2){gt[0][n][jp], gt[0][n][jp + 1]}, g1 = (f32x2){gt[1][n][jp], gt[1][n][jp + 1]}, g2 = (f32x2){gt[2][n][jp], gt[2][n][jp + 1]}, g3 = (f32x2){gt[3][n][jp], gt[3][n][jp + 1]};
                    f32x2 s3, s2; s3.x = dpp_old<0x111>(0.f, g3.x); s3.y = dpp_old<0x111>(0.f, g3.y); s2.x = dpp_old<0x111>(0.f, g2.x); s2.y = dpp_old<0x111>(0.f, g2.y);
                    const f32x2 k0 = (f32x2){w0[n][jp], w0[n][jp + 1]}, k1 = (f32x2){w1[n][jp], w1[n][jp + 1]}, k2 = (f32x2){w2[n][jp], w2[n][jp + 1]}, kb = (f32x2){bb[n][jp], bb[n][jp + 1]};
                    const f32x2 c0 = k0 * s2 + (k1 * s3 + (k2 * g0 + kb)), c1 = k0 * s3 + (k1 * g0 + (k2 * g1 + kb)), c2 = k0 * g0 + (k1 * g1 + (k2 * g2 + kb)), c3 = k0 * g1 + (k1 * g2 + (k2 * g3 + kb));
                    const f32x2 o0 = silu_mul2(c0, (f32x2){vv[0][n][jp], vv[0][n][jp + 1]}), o1 = silu_mul2(c1, (f32x2){vv[1][n][jp], vv[1][n][jp + 1]});
                    const f32x2 o2 = silu_mul2(c2, (f32x2){vv[2][n][jp], vv[2][n][jp + 1]}), o3 = silu_mul2(c3, (f32x2){vv[3][n][jp], vv[3][n][jp + 1]});
                    o[0][n][jp] = o0.x; o[0][n][jp + 1] = o0.y; o[1][n][jp] = o1.x; o[1][n][jp + 1] = o1.y; o[2][n][jp] = o2.x; o[2][n][jp + 1] = o2.y; o[3][n][jp] = o3.x; o[3][n][jp + 1] = o3.y; }
#pragma unroll
            for (int m = 0; m < 4; ++m) { const int row = UP_ROW(ai, m); const int r64 = 4 * fr + m; const size_t blk = (size_t)(row >> 6);
                if (r64 >= 2) { u32x4 w; w.x = cvt_pk_bf16(o[m][0][0], o[m][0][1]); w.y = cvt_pk_bf16(o[m][0][2], o[m][0][3]); w.z = cvt_pk_bf16(o[m][1][0], o[m][1][1]); w.w = cvt_pk_bf16(o[m][1][2], o[m][1][3]);
                    *(u32x4*)(act + (size_t)row * FF + ch0) = w; }
                else { u32x4 wg, wv; wg.x = cvt_pk_bf16(gt[m][0][0], gt[m][0][1]); wg.y = cvt_pk_bf16(gt[m][0][2], gt[m][0][3]); wg.z = cvt_pk_bf16(gt[m][1][0], gt[m][1][1]); wg.w = cvt_pk_bf16(gt[m][1][2], gt[m][1][3]);
                       wv.x = cvt_pk_bf16(vv[m][0][0], vv[m][0][1]); wv.y = cvt_pk_bf16(vv[m][0][2], vv[m][0][3]); wv.z = cvt_pk_bf16(vv[m][1][0], vv[m][1][1]); wv.w = cvt_pk_bf16(vv[m][1][2], vv[m][1][3]);
                       *(u32x4*)(bndg + (blk * 4 + 2 + r64) * FF + ch0) = wg; *(u32x4*)(act + (size_t)row * FF + ch0) = wv; }
                if (r64 >= 62) { u32x4 wg; wg.x = cvt_pk_bf16(gt[m][0][0], gt[m][0][1]); wg.y = cvt_pk_bf16(gt[m][0][2], gt[m][0][3]); wg.z = cvt_pk_bf16(gt[m][1][0], gt[m][1][1]); wg.w = cvt_pk_bf16(gt[m][1][2], gt[m][1][3]);
                    *(u32x4*)(bndg + (blk * 4 + (r64 - 62)) * FF + ch0) = wg; } } }
    }
#undef UP_ROW
};
struct EpiQkv {
    static constexpr bool PERM = true, ROWPERM = false;
    const float* ss; const float* qn; const float* kn; bf16_t* Q; bf16_t* Kb;
    __device__ __forceinline__ void operator()(AccRef acc, const Unit& u, int wr, int wc, int fr, int fq) const {
        const int part = u.pn >> 2, head = (u.pn & 3) * 4 + wc;
        const bf16_t* q_ = Q; const bf16_t* k_ = Kb; const float* qn_ = qn; const float* kn_ = kn;
        bf16_t* dst = (bf16_t*)((uintptr_t)q_ + (part > 0 ? (uintptr_t)k_ - (uintptr_t)q_ : 0));
        const float* gn = (const float*)((uintptr_t)qn_ + (part > 0 ? (uintptr_t)kn_ - (uintptr_t)qn_ : 0));
        const float post = part == 0 ? 0.125f * 1.44269504089f : 1.0f;
        f32x4 g[2][2]; float rs[2][4];
#pragma unroll
        for (int bj = 0; bj < 2; ++bj)
#pragma unroll
            for (int n = 0; n < 2; ++n) g[bj][n] = *(const f32x4*)(gn + 32 * bj + 8 * fq + 4 * n) * post;
#pragma unroll
        for (int ai = 0; ai < 2; ++ai)
#pragma unroll
            for (int m = 0; m < 4; ++m) rs[ai][m] = ss[EPI_ROW(ai, m)];
        EPI_FENCE();
#pragma unroll
        for (int ai = 0; ai < 2; ++ai)
#pragma unroll
            for (int m = 0; m < 4; ++m) { const int row = EPI_ROW(ai, m); const float rsc = __builtin_amdgcn_rsqf(rs[ai][m] * (1.0f / D) + EPS);
                f32x4 v[2][2]; float s = 0.f;
#pragma unroll
                for (int bj = 0; bj < 2; ++bj)
#pragma unroll
                    for (int n = 0; n < 2; ++n) { v[bj][n] = acc[ai][bj][m][n] * rsc; s += (v[bj][n][0] * v[bj][n][0] + v[bj][n][1] * v[bj][n][1]) + (v[bj][n][2] * v[bj][n][2] + v[bj][n][3] * v[bj][n][3]); }
                s += __shfl_xor(s, 16); s += __shfl_xor(s, 32);
                const float hr = __builtin_amdgcn_rsqf(s * (1.0f / 64.0f) + EPS);
#pragma unroll
                for (int bj = 0; bj < 2; ++bj) { f32x4 a = v[bj][0], b = v[bj][1];
                    a = a * hr * g[bj][0]; b = b * hr * g[bj][1];
                    u32x4 w; w.x = cvt_pk_bf16(a[0], a[1]); w.y = cvt_pk_bf16(a[2], a[3]); w.z = cvt_pk_bf16(b[0], b[1]); w.w = cvt_pk_bf16(b[2], b[3]);
                    *(u32x4*)(dst + (size_t)row * D + head * 64 + 32 * bj + 8 * fq) = w; } }
    }
};
struct EpiVt {
    static constexpr bool PERM = true, ROWPERM = false;
    const float* ss; bf16_t* Vt;
    __device__ __forceinline__ void operator()(AccRef acc, const Unit& u, int wr, int wc, int fr, int fq) const {
        f32x4 r0[2], r1[2];
#pragma unroll
        for (int bj = 0; bj < 2; ++bj) { const int tok0 = u.pn * 256 + bj * 128 + wc * 32 + 8 * fq; r0[bj] = *(const f32x4*)(ss + tok0); r1[bj] = *(const f32x4*)(ss + tok0 + 4); }
        EPI_FENCE();
#pragma unroll
        for (int bj = 0; bj < 2; ++bj) { const int tok0 = u.pn * 256 + bj * 128 + wc * 32 + 8 * fq;
#pragma unroll
            for (int j = 0; j < 4; ++j) { r0[bj][j] = __builtin_amdgcn_rsqf(r0[bj][j] * (1.0f / D) + EPS); r1[bj][j] = __builtin_amdgcn_rsqf(r1[bj][j] * (1.0f / D) + EPS); }
#pragma unroll
            for (int ai = 0; ai < 2; ++ai)
#pragma unroll
                for (int m = 0; m < 4; ++m) { const int row = EPI_ROW(ai, m); const f32x4 a = acc[ai][bj][m][0] * r0[bj], b = acc[ai][bj][m][1] * r1[bj];
                    u32x4 w; w.x = cvt_pk_bf16(a[0], a[1]); w.y = cvt_pk_bf16(a[2], a[3]); w.z = cvt_pk_bf16(b[0], b[1]); w.w = cvt_pk_bf16(b[2], b[3]);
                    *(u32x4*)(Vt + (size_t)row * M + tok0) = w; } }
    }
};

__device__ __forceinline__ void sincos_red(double ang, float& c, float& s) {
    const double q = __builtin_rint(ang * 0.63661977236758134308);
    double y = __builtin_fma(-q, 1.57079632679489655800, ang); y = __builtin_fma(-q, 6.123233995736766e-17, y);
    const int qi = (int)((long long)q & 3);
    const double y2 = y * y;
    const double sp = y * (1.0 + y2 * (-1.0 / 6 + y2 * (1.0 / 120 + y2 * (-1.0 / 5040 + y2 * (1.0 / 362880 + y2 * (-1.0 / 39916800 + y2 * (1.0 / 6227020800.0)))))));
    const double cp = 1.0 + y2 * (-0.5 + y2 * (1.0 / 24 + y2 * (-1.0 / 720 + y2 * (1.0 / 40320 + y2 * (-1.0 / 3628800 + y2 * (1.0 / 479001600.0))))));
    const float sf = (float)sp, cf = (float)cp;
    c = (qi == 0) ? cf : (qi == 1) ? -sf : (qi == 2) ? -cf : sf;
    s = (qi == 0) ? sf : (qi == 1) ? cf : (qi == 2) ? -sf : -cf;
}
__device__ __forceinline__ void p0_ssm_consts(int g, int qd, const float* lam_re, const float* lam_im, const float* b_re, const float* b_im, const float* c_re, const float* c_im, const float* log_dt,
                                              bf16_t* toep, bf16_t* wst, float* at, LAS float* L, int tid) {
    LAS float* AP = L; LAS float* BB = L + 4224; LAS float* CM = BB + 2048; LAS float* KM = CM + 2048;
    const double dt = exp((double)log_dt[g]);
    for (int it = tid; it < 64 * 33; it += 512) { const int p = it / 33, j = it % 33;
        const double re = (double)lam_re[g * 64 + p] * dt * j, im = (double)lam_im[g * 64 + p] * dt * j;
        float c, s; sincos_red(im, c, s); const float mg = (float)exp(re);
        AP[it * 2] = mg * c; AP[it * 2 + 1] = mg * s; }
    for (int it = tid; it < 1024; it += 512) { const int h = it >> 6, p = it & 63; CM[it * 2] = c_re[(g * 16 + h) * 64 + p]; CM[it * 2 + 1] = c_im[(g * 16 + h) * 64 + p]; }
    __syncthreads();
    for (int it = tid; it < 1024; it += 512) { const int p = it >> 4, h = it & 15;
        const float lr = lam_re[g * 64 + p], li = lam_im[g * 64 + p], xr = AP[(p * 33 + 1) * 2] - 1.0f, xi = AP[(p * 33 + 1) * 2 + 1];
        const float den = 1.0f / (lr * lr + li * li), zr = (xr * lr + xi * li) * den, zi = (xi * lr - xr * li) * den;
        const float br = b_re[(g * 64 + p) * 16 + h], bi = b_im[(g * 64 + p) * 16 + h];
        BB[it * 2] = zr * br - zi * bi; BB[it * 2 + 1] = zr * bi + zi * br; }
    if (qd == 0 && tid < 64) { at[(g * 64 + tid) * 2] = AP[(tid * 33 + 32) * 2]; at[(g * 64 + tid) * 2 + 1] = AP[(tid * 33 + 32) * 2 + 1]; }
    __syncthreads();
    for (int o = tid; o < 2048; o += 512) { const int j = o >> 6, hl = (o >> 4) & 3, hp = o & 15, h = 4 * qd + hl; float acc = 0.f;
        for (int p = 0; p < 64; ++p) { const float cr = CM[(h * 64 + p) * 2], ci = CM[(h * 64 + p) * 2 + 1], ar = AP[(p * 33 + j) * 2], ai = AP[(p * 33 + j) * 2 + 1];
            const float er = cr * ar - ci * ai, ei = cr * ai + ci * ar; acc += er * BB[(p * 16 + hp) * 2] - ei * BB[(p * 16 + hp) * 2 + 1]; }
        KM[o] = acc; }
    __syncthreads();
    bf16_t* tg = toep + (size_t)g * 512 * UP;
    for (int ci = tid; ci < 128 * 80; ci += 512) { const int rl = ci / 80, col0 = (ci % 80) * 8, t = rl >> 2, hl = rl & 3, h = 4 * qd + hl, row = t * 16 + h; float v[8];
        if (col0 < 512) { const int s = col0 >> 4, h0 = col0 & 15;
#pragma unroll
            for (int e = 0; e < 8; ++e) v[e] = (s <= t) ? KM[((t - s) * 4 + hl) * 16 + h0 + e] : 0.f; }
        else { const int q0 = col0 - 512; const bool imp = q0 >= 64; const int p0 = imp ? q0 - 64 : q0;
#pragma unroll
            for (int e = 0; e < 8; ++e) { const int p = p0 + e; const float cr = CM[(h * 64 + p) * 2], cim = CM[(h * 64 + p) * 2 + 1], ar = AP[(p * 33 + t + 1) * 2], aim = AP[(p * 33 + t + 1) * 2 + 1];
                v[e] = imp ? -(cr * aim + cim * ar) : (cr * ar - cim * aim); } }
        u32x4 w; w.x = pk2(v[0], v[1]); w.y = pk2(v[2], v[3]); w.z = pk2(v[4], v[5]); w.w = pk2(v[6], v[7]);
        *(u32x4*)(tg + (size_t)row * UP + col0) = w; }
    bf16_t* wg = wst + (size_t)g * 256 * 512;
    for (int ci = tid; ci < 64 * 64; ci += 512) { const int q = 64 * qd + (ci >> 6), col0 = (ci & 63) * 8, s = col0 >> 4, h0 = col0 & 15; float v[8];
        if (q < 128) { const bool imp = q >= 64; const int p = imp ? q - 64 : q; const float ar = AP[(p * 33 + 31 - s) * 2], aim = AP[(p * 33 + 31 - s) * 2 + 1];
#pragma unroll
            for (int e = 0; e < 8; ++e) { const float br = BB[(p * 16 + h0 + e) * 2], bi = BB[(p * 16 + h0 + e) * 2 + 1]; v[e] = imp ? (ar * bi + aim * br) : (ar * br - aim * bi); } }
        else {
#pragma unroll
            for (int e = 0; e < 8; ++e) v[e] = 0.f; }
        u32x4 w; w.x = pk2(v[0], v[1]); w.y = pk2(v[2], v[3]); w.z = pk2(v[4], v[5]); w.w = pk2(v[6], v[7]);
        *(u32x4*)(wg + (size_t)q * 512 + col0) = w; }
    __syncthreads();
}
__device__ __forceinline__ void p0_transpose_item(const float* W, int K, int Nsrc, const float* gain, bf16_t* WT, int k0, int srccol0, int dstrow0, LAS float* scr, int lane) {
    float v[32];
#pragma unroll
    for (int i = 0; i < 32; ++i) { const int kk = 2 * i + (lane >> 5); v[i] = W[(size_t)(k0 + kk) * Nsrc + srccol0 + (lane & 31)]; }
    if (gain) {
#pragma unroll
        for (int i = 0; i < 32; ++i) v[i] *= gain[k0 + 2 * i + (lane >> 5)]; }
#pragma unroll
    for (int i = 0; i < 32; ++i) scr[(2 * i + (lane >> 5)) * 33 + (lane & 31)] = v[i];
    asm volatile("s_waitcnt lgkmcnt(0)" ::: "memory");
    const int c = lane & 7;
#pragma unroll
    for (int j = 0; j < 4; ++j) { const int n = (lane >> 3) + 8 * j; const LAS float* s = scr + (8 * c) * 33 + n;
        u32x4 o; o.x = pk2(s[0 * 33], s[1 * 33]); o.y = pk2(s[2 * 33], s[3 * 33]); o.z = pk2(s[4 * 33], s[5 * 33]); o.w = pk2(s[6 * 33], s[7 * 33]);
        *(u32x4*)(WT + (size_t)(dstrow0 + n) * K + k0 + 8 * c) = o; }
    asm volatile("s_waitcnt lgkmcnt(0)" ::: "memory");
}
__device__ __forceinline__ int map_col(int kind, int n, int Fh) {
    if (kind == 1) { const int pn = n >> 8, half = (n >> 7) & 1, j = n & 127; return half * Fh + 128 * pn + j; }
    if (kind == 2) { const int pn = n >> 8, pos = n & 255, bj = pos >> 7, wc = (pos >> 5) & 3, i = pos & 31; return 256 * pn + 64 * wc + 32 * bj + i; }
    return n;
}

constexpr int KP = 72, VP = 68;
constexpr int SLOT_BYTES = 64 * KP * 2 + 64 * VP * 2, NSLOT = 7;
__device__ __forceinline__ void attn_phase(LAS unsigned char* lds, const bf16_t* Q, const bf16_t* Kb, const bf16_t* Vt, bf16_t* O, int G, int c) {
    LAS int* flags = (LAS int*)(lds + NSLOT * SLOT_BYTES);
    int tid_ = threadIdx.x; asm volatile("" : "+v"(tid_));
    const int tid = tid_, w = __builtin_amdgcn_readfirstlane(tid >> 6), lane = tid & 63, hf = lane >> 5, n = lane & 31;
    const int lrow = tid >> 3, lch = tid & 7;
#define ATT_KS(t) ((LAS bf16_t*)(lds + ((t) % NSLOT) * SLOT_BYTES))
#define ATT_VS(t) ((LAS bf16_t*)(lds + ((t) % NSLOT) * SLOT_BYTES + 64 * KP * 2))
#define ATT_WRITE(t, kr, vr) do { *(LAS u32x4*)(ATT_KS(t) + lrow * KP + 8 * lch) = kr; LAS u32x2* vp_ = (LAS u32x2*)(ATT_VS(t) + lrow * VP + 8 * lch); u32x2 lo_, hi_; lo_.x = vr.x; lo_.y = vr.y; hi_.x = vr.z; hi_.y = vr.w; vp_[0] = lo_; vp_[1] = hi_; } while (0)
    const int cx = (G % 8 == 0) ? (c & 7) * (G >> 3) + (c >> 3) : c;
    u32x4 pkr[5], pvr[5]; bf16x8 pqf[4];
#define ATT_PREFETCH(uix) do { const int qb_ = (uix) & 7, bh_ = (uix) >> 3, b_ = bh_ >> 4, h_ = bh_ & 15, kb_ = (qb_ * 256) >> 6; const size_t t0_ = (size_t)b_ * SEQ; \
        const bf16_t* kg_ = Kb + (t0_ + lrow) * D + h_ * 64 + 8 * lch; const bf16_t* vg_ = Vt + (size_t)(h_ * 64 + lrow) * M + t0_ + 8 * lch; \
        _Pragma("unroll") for (int i_ = 0; i_ < 5; ++i_) { const int t_ = kb_ - 1 + i_; if (t_ >= 0) { pkr[i_] = *(const u32x4*)(kg_ + (size_t)t_ * 64 * D); pvr[i_] = *(const u32x4*)(vg_ + t_ * 64); } } \
        _Pragma("unroll") for (int ds_ = 0; ds_ < 4; ++ds_) pqf[ds_] = *(const bf16x8*)(Q + (t0_ + qb_ * 256 + 32 * w + n) * D + h_ * 64 + 16 * ds_ + 8 * hf); } while (0)
#pragma unroll
    for (int i = 0; i < 5; ++i) { pkr[i] = (u32x4){0, 0, 0, 0}; pvr[i] = (u32x4){0, 0, 0, 0}; }
    if (cx < BATCH * 16 * 8) ATT_PREFETCH(cx);
    for (int ui = cx; ui < BATCH * 16 * 8; ui += G) {
        const int qb = ui & 7, bh = ui >> 3, b = bh >> 4, h = bh & 15, q0 = qb * 256;
        const size_t tok0 = (size_t)b * SEQ;
        const int qpos = q0 + 32 * w + n, kbase = q0 >> 6, kd = kbase + (w >> 1);
        bf16x8 qf[4];
#pragma unroll
        for (int ds = 0; ds < 4; ++ds) qf[ds] = pqf[ds];
        f32x16 o0, o1;
#pragma unroll
        for (int i = 0; i < 16; ++i) { o0[i] = 0.f; o1[i] = 0.f; }
        float carry = 1.0f; bool wdone = false;
        if (tid < 8) flags[tid] = 0;
        const bf16_t* kg = Kb + (tok0 + lrow) * D + h * 64 + 8 * lch;
        const bf16_t* vg = Vt + (size_t)(h * 64 + lrow) * M + tok0 + 8 * lch;
#pragma unroll
        for (int i = 0; i < 5; ++i) { const int t_ = kbase - 1 + i; if (t_ >= 0) ATT_WRITE(t_, pkr[i], pvr[i]); }
        if (ui + G < BATCH * 16 * 8) ATT_PREFETCH(ui + G);
        __syncthreads();
        for (int s = 0;; ++s) {
            if (s >= 2) {
                const int tn = kbase - s;
                if (tn >= 0) { const u32x4 kr_ = *(const u32x4*)(kg + (size_t)tn * 64 * D), vr_ = *(const u32x4*)(vg + tn * 64); ATT_WRITE(tn, kr_, vr_); }
                __syncthreads(); }
            const int t = kd - s;
            if (t < 0) wdone = true;
            if (!wdone) {
                const LAS bf16_t* Ks = ATT_KS(t); const LAS bf16_t* Vs = ATT_VS(t);
                const bool diag = (s == 0);
                const bool hi_ok = !(diag && ((w & 1) == 0));
#define ATT_HALF(kb, MASKED) do { \
                    f32x16 sa; _Pragma("unroll") for (int i_ = 0; i_ < 16; ++i_) sa[i_] = 0.f; \
                    _Pragma("unroll") for (int ds = 0; ds < 4; ++ds) { const bf16x8 ka = *(const LAS bf16x8*)(Ks + (32 * (kb) + n) * KP + 16 * ds + 8 * hf); sa = __builtin_amdgcn_mfma_f32_32x32x16_bf16(ka, qf[ds], sa, 0, 0, 0); } \
                    f32x2 E[2][4], I[2][4], W[2][4]; float tot[4], ptot[4], exg[4]; \
                    _Pragma("unroll") for (int pi = 0; pi < 2; ++pi) _Pragma("unroll") for (int j = 0; j < 4; ++j) { \
                        E[pi][j].x = __builtin_amdgcn_exp2f(__builtin_amdgcn_fmed3f(sa[8 * pi + j], -126.0f, 30.0f)); E[pi][j].y = __builtin_amdgcn_exp2f(__builtin_amdgcn_fmed3f(sa[8 * pi + 4 + j], -126.0f, 30.0f)); } \
                    if (MASKED) { _Pragma("unroll") for (int pi = 0; pi < 2; ++pi) _Pragma("unroll") for (int j = 0; j < 4; ++j) { const int key_ = 64 * t + 32 * (kb) + 16 * pi + 4 * hf + j; \
                        E[pi][j].x = (key_ >= qpos) ? 0.0f : E[pi][j].x; E[pi][j].y = (key_ + 8 >= qpos) ? 0.0f : E[pi][j].y; } } \
                    _Pragma("unroll") for (int pi = 0; pi < 2; ++pi) { const f32x2 d0 = E[pi][0] + 1.0f, d1 = E[pi][1] + 1.0f, d2 = E[pi][2] + 1.0f, d3 = E[pi][3] + 1.0f; \
                        const f32x2 b01 = d0 * d1, c012 = b01 * d2, dd = c012 * d3; f32x2 R; R.x = __builtin_amdgcn_rcpf(dd.x); R.y = __builtin_amdgcn_rcpf(dd.y); \
                        I[pi][0] = R; I[pi][1] = R * d0; I[pi][2] = R * b01; I[pi][3] = R * c012; tot[2 * pi] = R.x; tot[2 * pi + 1] = R.y; } \
                    _Pragma("unroll") for (int i_ = 0; i_ < 4; ++i_) ptot[i_] = __shfl_xor(tot[i_], 32); \
                    float run = carry; \
                    _Pragma("unroll") for (int idx = 3; idx >= 0; --idx) { const float a_ = hf ? 1.0f : ptot[idx]; exg[idx] = run * a_; run = (run * tot[idx]) * ptot[idx]; } \
                    carry = run; \
                    _Pragma("unroll") for (int pi = 0; pi < 2; ++pi) { const f32x2 ex2 = (f32x2){exg[2 * pi], exg[2 * pi + 1]}; _Pragma("unroll") for (int j = 0; j < 4; ++j) W[pi][j] = E[pi][j] * (ex2 * I[pi][j]); } \
                    _Pragma("unroll") for (int s2 = 0; s2 < 2; ++s2) { union { u32x4 u; bf16x8 v; } pf; \
                        pf.u.x = cvt_pk_bf16(W[s2][0].x, W[s2][1].x); pf.u.y = cvt_pk_bf16(W[s2][2].x, W[s2][3].x); pf.u.z = cvt_pk_bf16(W[s2][0].y, W[s2][1].y); pf.u.w = cvt_pk_bf16(W[s2][2].y, W[s2][3].y); \
                        _Pragma("unroll") for (int db = 0; db < 2; ++db) { const LAS bf16_t* vp = Vs + (32 * db + n) * VP + 32 * (kb) + 16 * s2 + 4 * hf; \
                            union { u32x4 u; bf16x8 v; } vf; const u32x2 lo = *(const LAS u32x2*)vp, hi = *(const LAS u32x2*)(vp + 8); vf.u.x = lo.x; vf.u.y = lo.y; vf.u.z = hi.x; vf.u.w = hi.y; \
                            if (db == 0) o0 = __builtin_amdgcn_mfma_f32_32x32x16_bf16(vf.v, pf.v, o0, 0, 0, 0); else o1 = __builtin_amdgcn_mfma_f32_32x32x16_bf16(vf.v, pf.v, o1, 0, 0, 0); } } \
                } while (0)
                bool lo_ok = true;
                if (hi_ok) { ATT_HALF(1, diag); lo_ok = (__ballot(carry >= 1e-15f) != 0ull); }
                if (lo_ok) ATT_HALF(0, diag && !hi_ok);
#undef ATT_HALF
                wdone = (__ballot(carry >= 1e-15f) == 0ull);
            }
            if (s >= 1) {
                if (lane == 0) flags[w] = wdone ? 1 : 0;
                __syncthreads();
                int all = 1;
#pragma unroll
                for (int i = 0; i < 8; ++i) all &= flags[i];
                if (all) break; }
        }
        { LAS bf16_t* Os = (LAS bf16_t*)(lds + w * (32 * 72 * 2));
#pragma unroll
          for (int i = 0; i < 4; ++i) { u32x2 a, bq; a.x = cvt_pk_bf16(o0[4 * i], o0[4 * i + 1]); a.y = cvt_pk_bf16(o0[4 * i + 2], o0[4 * i + 3]); bq.x = cvt_pk_bf16(o1[4 * i], o1[4 * i + 1]); bq.y = cvt_pk_bf16(o1[4 * i + 2], o1[4 * i + 3]);
              *(LAS u32x2*)(Os + n * 72 + 8 * i + 4 * hf) = a; *(LAS u32x2*)(Os + n * 72 + 32 + 8 * i + 4 * hf) = bq; }
          asm volatile("s_waitcnt lgkmcnt(0)" ::: "memory");
          const int orow = lane >> 3, och = lane & 7;
#pragma unroll
          for (int k = 0; k < 4; ++k) { const u32x4 v = *(const LAS u32x4*)(Os + (8 * k + orow) * 72 + 8 * och);
              *(u32x4*)(O + (tok0 + q0 + 32 * w + 8 * k + orow) * D + h * 64 + 8 * och) = v; } }
        __syncthreads();
    }
#undef ATT_KS
#undef ATT_VS
#undef ATT_WRITE
#undef ATT_PREFETCH
}

#define XB_TMO      128
#define XB_XCNT(j)  (256  + 64 * (j))
#define XB_XSUB(j)  (1280 + 64 * (j))
#define XB_XGEN(j)  (2304 + 64 * (j))
#define XB_TOP      3328
#define XB_TOPGEN   3392
#define XCD_BAR_WORDS 3456
#define XB_SPIN_CAP (1u << 20)
__device__ __forceinline__ unsigned xb_ld(unsigned* p)              { return __hip_atomic_load(p, __ATOMIC_RELAXED, __HIP_MEMORY_SCOPE_AGENT); }
__device__ __forceinline__ unsigned xb_add(unsigned* p, unsigned v) { return __hip_atomic_fetch_add(p, v, __ATOMIC_RELAXED, __HIP_MEMORY_SCOPE_AGENT); }
__device__ __forceinline__ unsigned xb_xcc_id() { return (unsigned)__builtin_amdgcn_s_getreg((3 << 11) | 20) & 0xFu; }
#define XB_SPIN(cond, bar) do { unsigned _sp = 0; while (cond) { __builtin_amdgcn_s_sleep(1); \
    if ((++_sp & 255u) == 0u) { if (xb_ld(&(bar)[XB_TMO])) break; if (_sp > XB_SPIN_CAP) { atomicAdd(&(bar)[XB_TMO], 1u); break; } } } } while (0)
struct XcdBarrier { unsigned* bar; unsigned x; volatile LAS unsigned* st; };
__device__ __forceinline__ unsigned xcd_barrier_post(unsigned* bar, unsigned x) { return xb_add(&bar[XB_XCNT(x)], 1u); }
__device__ __forceinline__ void xcd_barrier_complete(unsigned* bar, unsigned x, unsigned& nloc, unsigned& nx) {
    const unsigned G = gridDim.x * gridDim.y * gridDim.z;
    unsigned sum, cnt, mine, sp = 0u;
    for (;;) {
        sum = 0u; cnt = 0u; mine = 0u;
#pragma unroll
        for (unsigned j = 0; j < 16; ++j) { const unsigned c = xb_ld(&bar[XB_XCNT(j)]); sum += c; cnt += (c > 0u) ? 1u : 0u; mine = (j == x) ? c : mine; }
        if (sum == G) break;
        __builtin_amdgcn_s_sleep(1);
        if ((++sp & 255u) == 0u) { if (xb_ld(&bar[XB_TMO])) break; if (sp > XB_SPIN_CAP) { atomicAdd(&bar[XB_TMO], 1u); break; } }
    }
    nloc = mine > 0u ? mine : 1u; nx = cnt > 0u ? cnt : 1u;
}
__device__ __forceinline__ void xcd_barrier(const XcdBarrier& b) {
    asm volatile("s_waitcnt vmcnt(0)" ::: "memory");
    __syncthreads();
    if (threadIdx.x == 0) {
        unsigned* bar = b.bar;
        __builtin_amdgcn_s_waitcnt(0);
        unsigned nloc = b.st[0], nx = b.st[1];
        if (nloc == 0u) { xcd_barrier_complete(bar, b.x, nloc, nx); b.st[0] = nloc; b.st[1] = nx; }
        const unsigned old = xb_add(&bar[XB_XSUB(b.x)], 1u);
        const unsigned gen = old / nloc;
        if (old + 1u == (gen + 1u) * nloc) {
            __builtin_amdgcn_fence(__ATOMIC_RELEASE, "agent");
            asm volatile("s_waitcnt vmcnt(0)" ::: "memory");
            const unsigned og = xb_add(&bar[XB_TOP], 1u);
            const unsigned tg = og / nx;
            if (og + 1u == (tg + 1u) * nx) xb_add(&bar[XB_TOPGEN], 1u);
            else XB_SPIN(xb_ld(&bar[XB_TOPGEN]) == tg, bar);
            __builtin_amdgcn_fence(__ATOMIC_ACQUIRE, "agent");
            xb_add(&bar[XB_XGEN(b.x)], 1u);
            asm volatile("s_waitcnt vmcnt(0)" ::: "memory");
        } else {
            XB_SPIN(xb_ld(&bar[XB_XGEN(b.x)]) == gen, bar);
            __builtin_amdgcn_fence(__ATOMIC_ACQUIRE, "agent");
            asm volatile("s_waitcnt vmcnt(0)" ::: "memory");
        }
    }
    __syncthreads();
}
constexpr int LDS_VCU = 131072 + 128;
constexpr int LDS_BARST = 131072 + 64;
constexpr size_t WS_BAR = 16384;

struct Args { const float* in[24]; float* out; unsigned char* ws; };
#define CAS __attribute__((address_space(4)))
__device__ __forceinline__ const CAS Args* fresh_args() { const CAS Args* p = (const CAS Args*)__builtin_amdgcn_kernarg_segment_ptr(); asm volatile("" : "+s"(p)); return p; }
#define WSP(T, off) ((T*)(ws + (off)))
#define GRID_BAR() do { const CAS Args* A_ = fresh_args(); XcdBarrier b_; b_.bar = (unsigned*)(A_->ws + WS_BAR); b_.x = xb_xcc_id(); b_.st = (volatile LAS unsigned*)(lds + LDS_BARST); xcd_barrier(b_); } while (0)
__global__ void __launch_bounds__(512, 2) yoco_fwd(Args a_unused) {
    extern __shared__ __attribute__((aligned(16))) unsigned char lds_raw[];
    LAS unsigned char* lds = (LAS unsigned char*)lds_raw;
    cg::grid_group grid = cg::this_grid();
    if (threadIdx.x < 2) ((LAS unsigned*)(lds + LDS_BARST))[threadIdx.x] = 0u;
    if (blockIdx.x == 0) { const CAS Args* A_ = fresh_args(); unsigned* bar_ = (unsigned*)(A_->ws + WS_BAR); for (int i = threadIdx.x; i < XCD_BAR_WORDS; i += 512) bar_[i] = 0u; }
    __syncthreads();

    {
        const CAS Args* A = fresh_args(); unsigned char* ws = A->ws;
        int tid_ = threadIdx.x; asm volatile("" : "+v"(tid_));
        const int tid = tid_, lane = tid & 63, wave = __builtin_amdgcn_readfirstlane(tid >> 6), G = gridDim.x, bx = blockIdx.x;
        for (int gq = bx; gq < NG * 4; gq += G) p0_ssm_consts(gq >> 2, gq & 3, A->in[3], A->in[4], A->in[5], A->in[6], A->in[7], A->in[8], A->in[10], WSP(bf16_t, WS_TOEP), WSP(bf16_t, WS_WST), WSP(float, WS_AT), (LAS float*)lds, tid);
        const int gw = bx * 8 + wave, NGW = G * 8;
        LAS float* scr = (LAS float*)(lds + wave * 16384);
        for (int it = gw; it < 12032; it += NGW) {
            int r = it; const float* W; const float* gain = nullptr; bf16_t* dst; int K = 1024, Nsrc, Ndst, kind = 0, Fh = 0, base = 0;
            if (r < 512) { W = A->in[2]; gain = A->in[1]; dst = WSP(bf16_t, WS_WIN); Nsrc = 1024; Ndst = 1024; }
            else if ((r -= 512) < 1024) { W = A->in[11]; dst = WSP(bf16_t, WS_WGLU); Nsrc = 2048; Ndst = 2048; kind = 1; Fh = 1024; }
            else if ((r -= 1024) < 512) { W = A->in[16]; gain = A->in[15]; dst = WSP(bf16_t, WS_WQKV); Nsrc = 1024; Ndst = 1024; kind = 2; }
            else if ((r -= 512) < 512) { W = A->in[13]; gain = A->in[12]; dst = WSP(bf16_t, WS_WQKV) + (size_t)1024 * 1024; Nsrc = 2048; Ndst = 1024; kind = 2; }
            else if ((r -= 512) < 512) { W = A->in[13]; gain = A->in[12]; dst = WSP(bf16_t, WS_WQKV) + (size_t)2048 * 1024; Nsrc = 2048; Ndst = 1024; kind = 0; base = 1024; }
            else if ((r -= 512) < 512) { W = A->in[18]; dst = WSP(bf16_t, WS_WO); Nsrc = 1024; Ndst = 1024; }
            else if ((r -= 512) < 2816) { W = A->in[20]; gain = A->in[19]; dst = WSP(bf16_t, WS_UP0); Nsrc = 2 * FF; Ndst = 2 * FF; kind = 1; Fh = FF; }
            else if ((r -= 2816) < 2816) { W = A->in[20] + (size_t)D * 2 * FF; gain = A->in[19] + D; dst = WSP(bf16_t, WS_UP1); Nsrc = 2 * FF; Ndst = 2 * FF; kind = 1; Fh = FF; }
            else if ((r -= 2816) < 1408) { W = A->in[23]; dst = WSP(bf16_t, WS_DN0); K = FF; Nsrc = 1024; Ndst = 1024; }
            else { r -= 1408; W = A->in[23] + (size_t)FF * D; dst = WSP(bf16_t, WS_DN1); K = FF; Nsrc = 1024; Ndst = 1024; }
            const int nblk = Ndst / 32, kb = r / nblk, nb = r % nblk;
            p0_transpose_item(W, K, Nsrc, gain, dst, 64 * kb, base + map_col(kind, 32 * nb, Fh), 32 * nb, scr, lane);
        }
        const float* x = A->in[0]; float* rstd0 = WSP(float, WS_RSTD0); bf16_t* XB = WSP(bf16_t, WS_XB);
        for (int m = gw; m < M; m += 4 * NGW) {
            f32x4 v[4][4]; float sq[4];
#pragma unroll
            for (int r = 0; r < 4; ++r) { const f32x4* xr = (const f32x4*)(x + (size_t)(m + r * NGW) * D) + lane;
#pragma unroll
                for (int j = 0; j < 4; ++j) v[r][j] = xr[64 * j]; }
#pragma unroll
            for (int r = 0; r < 4; ++r) { float q = 0.f;
#pragma unroll
                for (int j = 0; j < 4; ++j) q += (v[r][j][0] * v[r][j][0] + v[r][j][1] * v[r][j][1]) + (v[r][j][2] * v[r][j][2] + v[r][j][3] * v[r][j][3]);
                sq[r] = wave_sum(q); }
#pragma unroll
            for (int r = 0; r < 4; ++r) { if (lane == 0) rstd0[m + r * NGW] = 1.0f / sqrtf(sq[r] * (1.0f / D) + EPS);
                u32x2* o8 = (u32x2*)(XB + (size_t)(m + r * NGW) * D) + lane;
#pragma unroll
                for (int j = 0; j < 4; ++j) { u32x2 w; w.x = pk2(v[r][j][0], v[r][j][1]); w.y = pk2(v[r][j][2], v[r][j][3]); o8[64 * j] = w; } }
        }
        float* ss1 = WSP(float, WS_SS1);
        for (int i = bx * 512 + tid; i < 3 * M; i += G * 512) ss1[i] = 0.f;
    }
    grid.sync();
    if (threadIdx.x == 0) {
        const CAS Args* A_ = fresh_args(); unsigned* bar_ = (unsigned*)(A_->ws + WS_BAR); const unsigned x_ = xb_xcc_id(); const unsigned rk_ = xcd_barrier_post(bar_, x_);
        unsigned nloc_, nx_; xcd_barrier_complete(bar_, x_, nloc_, nx_);
        ((volatile LAS unsigned*)(lds + LDS_BARST))[0] = nloc_; ((volatile LAS unsigned*)(lds + LDS_BARST))[1] = nx_;
        bool ok_ = (gridDim.x % 8u) == 0u;
        for (unsigned j = 0; j < 16; ++j) { const unsigned cnt_ = xb_ld(&bar_[XB_XCNT(j)]); ok_ = ok_ && (cnt_ == (j < 8u ? gridDim.x / 8u : 0u)); }
        ((LAS unsigned*)(lds + LDS_VCU))[0] = ok_ ? rk_ * 8u + x_ : blockIdx.x; }
    __syncthreads();
#define VCU() ((int)__builtin_amdgcn_readfirstlane(((volatile LAS unsigned*)(lds + LDS_VCU))[0]))


    { const CAS Args* A = fresh_args(); unsigned char* ws = A->ws; pg8::StaticOrder S;
      pg8::Gemm g{WSP(bf16_t, WS_XB), WSP(bf16_t, WS_WIN), M, D, D, 2 * D, 32, 0}; S.init(M, D, gridDim.x, VCU()); EpiU E{WSP(float, WS_RSTD0), WSP(bf16_t, WS_UBUF)}; pg8::gemm_phase(lds, g, S, E); }
    GRID_BAR();
    { const CAS Args* A = fresh_args(); unsigned char* ws = A->ws; pg8::StaticOrder S;
      pg8::Gemm g{WSP(bf16_t, WS_UBUF), WSP(bf16_t, WS_WST), NG * 2048, 256, 512, 2 * UP, 32, (size_t)256 * 512 * 2}; S.init(NG * 2048, 256, gridDim.x, VCU()); EpiSloc E{WSP(float, WS_SLOC)}; pg8::gemm_phase(lds, g, S, E); }
    GRID_BAR();
    { const CAS Args* A = fresh_args(); unsigned char* ws = A->ws; const float* AT = WSP(float, WS_AT); const float* SLOC = WSP(float, WS_SLOC); bf16_t* UBUF = WSP(bf16_t, WS_UBUF);
      int tid_ = threadIdx.x; asm volatile("" : "+v"(tid_));
      for (int gid = blockIdx.x * 512 + tid_; gid < NG * BATCH * 64; gid += gridDim.x * 512) {
        const int p = gid & 63, b = (gid >> 6) & 31, g = gid >> 11; const float ar = AT[(g * 64 + p) * 2], ai = AT[(g * 64 + p) * 2 + 1];
        float hr = 0.f, hi = 0.f; const size_t r0 = (size_t)g * 2048 + b * 64;
        for (int c0 = 0; c0 < NCH; c0 += 8) { float sr[8], si[8];
#pragma unroll
            for (int k = 0; k < 8; ++k) { sr[k] = SLOC[(r0 + c0 + k) * 128 + p]; si[k] = SLOC[(r0 + c0 + k) * 128 + 64 + p]; }
#pragma unroll
            for (int k = 0; k < 8; ++k) { bf16_t* up = UBUF + (r0 + c0 + k) * UP + 512 + p; up[0] = (bf16_t)f2bf(hr); up[64] = (bf16_t)f2bf(hi);
                const float nr = ar * hr - ai * hi + sr[k], ni = ar * hi + ai * hr + si[k]; hr = nr; hi = ni; } }
      } }
    GRID_BAR();
    { const CAS Args* A = fresh_args(); unsigned char* ws = A->ws; pg8::StaticOrder S;
      pg8::Gemm g{WSP(bf16_t, WS_UBUF), WSP(bf16_t, WS_TOEP), NG * 2048, 512, UP, 2 * UP, 32, (size_t)512 * UP * 2}; S.init(NG * 2048, 512, gridDim.x, VCU());
      EpiSsmOut E{WSP(bf16_t, WS_UBUF), A->in[9], WSP(bf16_t, WS_GBUF)}; pg8::gemm_phase(lds, g, S, E); }
    GRID_BAR();
    { const CAS Args* A = fresh_args(); unsigned char* ws = A->ws; pg8::StaticOrder S;
      pg8::Gemm g{WSP(bf16_t, WS_GBUF), WSP(bf16_t, WS_WGLU), M, 2 * D, D, 32, (unsigned)((size_t)M * 16 * 2), 0}; S.init(M, 2 * D, gridDim.x, VCU());
      EpiGlu E{WSP(bf16_t, WS_XB), WSP(bf16_t, WS_HB), WSP(float, WS_SS1)}; pg8::gemm_phase(lds, g, S, E); }
    GRID_BAR();
#pragma unroll 1
    for (int layer = 0; layer < 2; ++layer) {
        if (layer == 1) {
            { const CAS Args* A = fresh_args(); unsigned char* ws = A->ws; pg8::StaticOrder S;
              pg8::Gemm g{WSP(bf16_t, WS_HB), WSP(bf16_t, WS_WQKV), M, 2 * D, D, 2 * D, 32, 0}; S.init(M, 2 * D, gridDim.x, VCU());
              EpiQkv E{WSP(float, WS_SS2), A->in[17], A->in[14], WSP(bf16_t, WS_Q), WSP(bf16_t, WS_K)}; pg8::gemm_phase(lds, g, S, E); }
            { const CAS Args* A = fresh_args(); unsigned char* ws = A->ws; pg8::StaticOrder S;
              pg8::Gemm g{WSP(bf16_t, WS_WQKV) + (size_t)2048 * 1024, WSP(bf16_t, WS_HB), D, M, D, 2 * D, 32, 0}; S.init(D, M, gridDim.x, VCU());
              EpiVt E{WSP(float, WS_SS2), WSP(bf16_t, WS_V)}; pg8::gemm_phase(lds, g, S, E); }
            GRID_BAR();
            { const CAS Args* A = fresh_args(); unsigned char* ws = A->ws; attn_phase(lds, WSP(bf16_t, WS_Q), WSP(bf16_t, WS_K), WSP(bf16_t, WS_V), WSP(bf16_t, WS_O), gridDim.x, VCU()); }
            GRID_BAR();
            { const CAS Args* A = fresh_args(); unsigned char* ws = A->ws; pg8::StaticOrder S;
              pg8::Gemm g{WSP(bf16_t, WS_O), WSP(bf16_t, WS_WO), M, D, D, 2 * D, 32, 0}; S.init(M, D, gridDim.x, VCU()); EpiResid<false> E{nullptr, WSP(bf16_t, WS_HB), WSP(float, WS_SS3)}; pg8::gemm_phase(lds, g, S, E); }
            GRID_BAR();
        }
        { const CAS Args* A = fresh_args(); unsigned char* ws = A->ws; pg8::StaticOrder S;
          pg8::Gemm g{WSP(bf16_t, WS_HB), WSP(bf16_t, WS_UP0 + (size_t)layer * (WS_UP1 - WS_UP0)), M, 2 * FF, D, 2 * D, 32, 0}; S.init(M, 2 * FF, gridDim.x, VCU());
          EpiUp E{WSP(float, WS_SS1 + (size_t)layer * (WS_SS3 - WS_SS1)), A->in[21] + (size_t)layer * 3 * FF, A->in[22] + (size_t)layer * FF, WSP(bf16_t, WS_ACT), WSP(bf16_t, WS_BNDG)}; pg8::gemm_phase(lds, g, S, E); }
        GRID_BAR();
        { const CAS Args* A = fresh_args(); unsigned char* ws = A->ws; const float* cw = A->in[21] + (size_t)layer * 3 * FF; const float* cb = A->in[22] + (size_t)layer * FF;
          const bf16_t* BNDG = WSP(bf16_t, WS_BNDG); bf16_t* ACT = WSP(bf16_t, WS_ACT);
          int tid_ = threadIdx.x; asm volatile("" : "+v"(tid_));
          for (int i = blockIdx.x * 512 + tid_; i < 1024 * 2 * (FF / 8); i += gridDim.x * 512) { const int c8 = i % (FF / 8), r = (i / (FF / 8)) & 1, k = i / (2 * (FF / 8)); const int ch = 8 * c8;
            const u32x4 zero = (u32x4){0, 0, 0, 0}; const bool first = (k & 31) == 0;
            const u32x4 qm2 = first ? zero : *(const u32x4*)(BNDG + ((size_t)(k - 1) * 4 + 0) * FF + ch), qm1 = first ? zero : *(const u32x4*)(BNDG + ((size_t)(k - 1) * 4 + 1) * FF + ch);
            const u32x4 q0 = *(const u32x4*)(BNDG + ((size_t)k * 4 + 2) * FF + ch), q1 = *(const u32x4*)(BNDG + ((size_t)k * 4 + 3) * FF + ch);
            bf16_t* ap = ACT + ((size_t)k * 64 + r) * FF + ch; const u32x4 qv = *(const u32x4*)ap;
            const u32x4 ta = r == 0 ? qm2 : qm1, tb = r == 0 ? qm1 : q0, tc = r == 0 ? q0 : q1;
            float res[8];
#pragma unroll
            for (int e = 0; e < 8; ++e) { const unsigned wa = e < 2 ? ta.x : e < 4 ? ta.y : e < 6 ? ta.z : ta.w, wb = e < 2 ? tb.x : e < 4 ? tb.y : e < 6 ? tb.z : tb.w, wc_ = e < 2 ? tc.x : e < 4 ? tc.y : e < 6 ? tc.z : tc.w, wv = e < 2 ? qv.x : e < 4 ? qv.y : e < 6 ? qv.z : qv.w;
                const float fa = (e & 1) ? bf_hi(wa) : bf_lo(wa), fb = (e & 1) ? bf_hi(wb) : bf_lo(wb), fc = (e & 1) ? bf_hi(wc_) : bf_lo(wc_), fv = (e & 1) ? bf_hi(wv) : bf_lo(wv);
                const float gc = cb[ch + e] + cw[ch + e] * fa + cw[FF + ch + e] * fb + cw[2 * FF + ch + e] * fc;
                res[e] = gc * sigmoidf_(gc) * fv; }
            u32x4 w; w.x = pk2(res[0], res[1]); w.y = pk2(res[2], res[3]); w.z = pk2(res[4], res[5]); w.w = pk2(res[6], res[7]);
            *(u32x4*)ap = w; } }
        GRID_BAR();
        if (layer == 0) { { const CAS Args* A = fresh_args(); unsigned char* ws = A->ws; pg8::StaticOrder S;
            pg8::Gemm g{WSP(bf16_t, WS_ACT), WSP(bf16_t, WS_DN0), M, D, FF, 2 * FF, 32, 0}; S.init(M, D, gridDim.x, VCU()); EpiResid<false> E{nullptr, WSP(bf16_t, WS_HB), WSP(float, WS_SS2)}; pg8::gemm_phase(lds, g, S, E); }
            GRID_BAR(); }
        else { const CAS Args* A = fresh_args(); unsigned char* ws = A->ws; pg8::StaticOrder S;
            pg8::Gemm g{WSP(bf16_t, WS_ACT), WSP(bf16_t, WS_DN1), M, D, FF, 2 * FF, 32, 0}; S.init(M, D, gridDim.x, VCU()); EpiResid<true> E{A->out, WSP(bf16_t, WS_HB), nullptr}; pg8::gemm_phase(lds, g, S, E); }
    }
}

extern "C" void kernel_launch(void* const* d_in, const int* in_sizes, int n_in, void* d_out, int out_size, void* d_ws, size_t ws_size, hipStream_t stream) {
    static int grid = 0;
    if (grid == 0) {
        if (n_in != 24 || in_sizes[0] != M * D || out_size != M * D || ws_size < WS_END) { fprintf(stderr, "kernel_launch: unexpected shapes (n_in %d, in0 %d, out %d, ws %zu)\n", n_in, n_in > 0 ? in_sizes[0] : -1, out_size, ws_size); grid = -1; return; }
        int dev = 0, cus = 0, per_cu = 0;
        hipGetDevice(&dev); hipDeviceGetAttribute(&cus, hipDeviceAttributeMultiprocessorCount, dev);
        if (hipFuncSetAttribute((const void*)yoco_fwd, hipFuncAttributeMaxDynamicSharedMemorySize, LDS_BYTES) != hipSuccess) { fprintf(stderr, "kernel_launch: hipFuncSetAttribute failed\n"); grid = -1; return; }
        if (hipOccupancyMaxActiveBlocksPerMultiprocessor(&per_cu, (const void*)yoco_fwd, 512, LDS_BYTES) != hipSuccess || per_cu < 1) { fprintf(stderr, "kernel_launch: occupancy query says %d\n", per_cu); per_cu = 1; }
        (void)hipGetLastError();
        grid = cus;
    }
    if (grid < 0) return;
    Args a{};
    for (int i = 0; i < 24; ++i) a.in[i] = (const float*)d_in[i];
    a.out = (float*)d_out; a.ws = (unsigned char*)d_ws;
    void* args[] = {&a};
    hipError_t e = hipLaunchCooperativeKernel((const void*)yoco_fwd, dim3(grid), dim3(512), args, LDS_BYTES, stream);
    if (e != hipSuccess) fprintf(stderr, "cooperative launch failed: %s (grid %d)\n", hipGetErrorString(e), grid);
}
```
